# Optimizing an MI355X kernel written in HIP

```python
import math
import jax, jax.numpy as jnp
from jax import lax
import numpy as np

D_MODEL = 1024
BATCH = 8
SEQ = 2048
DEPTH = 4
DEC_BATCH = 128
DEC_SEQ = 8
PAST_LEN = 16384
PAGE_SIZE = 128

N_MIXERS = 2
N_A = (DEPTH + 1) // 2
N_B = DEPTH // 2
H_DN = 8
DK = 128
DV = 128
QKV_DIM = 2 * H_DN * DK + H_DN * DV
A_IN_DIM = QKV_DIM + H_DN * DV + 2 * H_DN
DN_CONV = 4
CHUNK = 64
SC_CONV = 3
D_FF = 2816
FFN_CONV = 3
D_PLE = 256
ALPHA = (2.0 * DEPTH) ** 0.25
BETA_INIT = (8.0 * DEPTH) ** -0.25
LN_EPS = 1e-5
RMS_EPS = 1e-6
L2_EPS = 1e-6

kernel_name = 'hybrid_deltanet_shortconv_convffn_step'


def layer_norm(x, g, b):
    xf = x.astype(jnp.float32)
    mu = jnp.mean(xf, -1, keepdims=True)
    var = jnp.mean(jnp.square(xf - mu), -1, keepdims=True)
    y = (xf - mu) * lax.rsqrt(var + LN_EPS) * g.astype(jnp.float32) + b.astype(jnp.float32)
    return y.astype(x.dtype)


def causal_dwconv(u, w, buf):
    W = w.shape[0]
    L = u.shape[1]
    ext = jnp.concatenate([buf.astype(u.dtype), u], axis=1)
    y = ext[:, 0:L] * w[0]
    for j in range(1, W):
        y = y + ext[:, j:j + L] * w[j]
    return y, ext[:, ext.shape[1] - (W - 1):]


def l2norm(t):
    return t * lax.rsqrt(jnp.sum(t * t, -1, keepdims=True) + L2_EPS)


def gated_delta_chunked(q, k, v, g, beta, S0):
    B, L, H, _ = q.shape
    C = min(CHUNK, L)
    pad = (-L) % C
    if pad:
        pw = ((0, 0), (0, pad), (0, 0), (0, 0))
        q = jnp.pad(q, pw); k = jnp.pad(k, pw); v = jnp.pad(v, pw)
        g = jnp.pad(g, pw[:3]); beta = jnp.pad(beta, pw[:3])
    N = (L + pad) // C

    def chunks(t):
        t = t.reshape((B, N, C, H) + t.shape[3:])
        return jnp.moveaxis(t, (1, 3), (0, 2))

    q = chunks(q) * (DK ** -0.5)
    k = chunks(k)
    v = chunks(v)
    gc = jnp.cumsum(chunks(g), axis=-1)
    bt = chunks(beta)[..., None]
    kb = k * bt
    vb = v * bt
    idx = jnp.arange(C)
    causal = idx[:, None] >= idx[None, :]
    strict = idx[:, None] > idx[None, :]
    decay = jnp.exp(jnp.where(causal, gc[..., :, None] - gc[..., None, :], -jnp.inf))
    A = jnp.where(strict, jnp.einsum('nbhid,nbhjd->nbhij', kb, k) * decay, 0.0)
    rhs = jnp.concatenate([vb, kb * jnp.exp(gc)[..., None]], axis=-1)
    sol = lax.linalg.triangular_solve(A + jnp.eye(C, dtype=A.dtype), rhs,
                                      left_side=True, lower=True, unit_diagonal=True)
    u = sol[..., :DV]
    w = sol[..., DV:]
    att = jnp.einsum('nbhid,nbhjd->nbhij', q, k) * decay

    def step(S, xs):
        q_c, k_c, u_c, w_c, gc_c, att_c = xs
        v_new = u_c - jnp.einsum('bhck,bhkv->bhcv', w_c, S)
        o = (jnp.einsum('bhck,bhkv->bhcv', q_c * jnp.exp(gc_c)[..., None], S)
             + jnp.einsum('bhij,bhjv->bhiv', att_c, v_new))
        g_last = gc_c[..., -1]
        S = (S * jnp.exp(g_last)[..., None, None]
             + jnp.einsum('bhck,bhcv->bhkv', k_c * jnp.exp(g_last[..., None] - gc_c)[..., None], v_new))
        return S, o

    S, o = lax.scan(step, S0, (q, k, u, w, gc, att))
    o = jnp.moveaxis(o, (0, 2), (1, 3)).reshape(B, N * C, H, DV)[:, :L]
    return o, S


def delta_mixer(x, conv_buf, S0, w_in, conv_w, a_log, dt_bias, norm_g, w_out):
    B, L, _ = x.shape
    proj = x @ w_in
    qkv = proj[..., :QKV_DIM]
    z = proj[..., QKV_DIM:QKV_DIM + H_DN * DV]
    ba = proj[..., QKV_DIM + H_DN * DV:].astype(jnp.float32)
    qkv_c, new_buf = causal_dwconv(qkv, conv_w, conv_buf)
    qkv_c = jax.nn.silu(qkv_c.astype(jnp.float32))
    q = l2norm(qkv_c[..., :H_DN * DK].reshape(B, L, H_DN, DK))
    k = l2norm(qkv_c[..., H_DN * DK:2 * H_DN * DK].reshape(B, L, H_DN, DK))
    v = qkv_c[..., 2 * H_DN * DK:].reshape(B, L, H_DN, DV)
    beta = jax.nn.sigmoid(ba[..., :H_DN])
    g = -jnp.exp(a_log.astype(jnp.float32)) * jax.nn.softplus(ba[..., H_DN:] + dt_bias.astype(jnp.float32))
    o, S = gated_delta_chunked(q, k, v, g, beta, S0.astype(jnp.float32))
    o = (o * lax.rsqrt(jnp.mean(o * o, -1, keepdims=True) + RMS_EPS) * norm_g.astype(jnp.float32)
         * jax.nn.silu(z.astype(jnp.float32).reshape(B, L, H_DN, DV)))
    y = o.reshape(B, L, H_DN * DV).astype(x.dtype) @ w_out
    return y, new_buf, S.astype(S0.dtype)


def shortconv_mixer(x, buf, w_in, conv_w, w_out):
    proj = x @ w_in
    b = proj[..., :D_MODEL]
    c = proj[..., D_MODEL:2 * D_MODEL]
    h = proj[..., 2 * D_MODEL:]
    uc, new_buf = causal_dwconv(c * h, conv_w, buf)
    return (b * uc) @ w_out, new_buf


def conv_ffn(x, buf, w_up, conv_w, w_down):
    hc, new_buf = causal_dwconv(x @ w_up, conv_w, buf)
    return (jax.nn.silu(hc[..., D_FF:]) * hc[..., :D_FF]) @ w_down, new_buf


def trunk(x, p, dn_conv, dn_S, sc_conv, ffn_conv,
          dn_w_in, dn_conv_w, dn_a_log, dn_dt_bias, dn_norm_g, dn_w_out,
          sc_w_in, sc_conv_w, sc_w_out, ffn_w_up, ffn_conv_w, ffn_w_down,
          ln_mix_g, ln_mix_b, ln_ffn_g, ln_ffn_b, ple_w_proj, ple_w_gate):
    new_dn_conv, new_dn_S, new_sc, new_ffn = [], [], [], []
    for i in range(DEPTH):
        j = i // N_MIXERS
        if i % N_MIXERS == 0:
            mix, cb, S = delta_mixer(x, dn_conv[j], dn_S[j], dn_w_in[j], dn_conv_w[j], dn_a_log[j],
                                     dn_dt_bias[j], dn_norm_g[j], dn_w_out[j])
            new_dn_conv.append(cb)
            new_dn_S.append(S)
        else:
            mix, sb = shortconv_mixer(x, sc_conv[j], sc_w_in[j], sc_conv_w[j], sc_w_out[j])
            new_sc.append(sb)
        x = layer_norm(ALPHA * x + mix, ln_mix_g[i], ln_mix_b[i])
        f, fb = conv_ffn(x, ffn_conv[i], ffn_w_up[i], ffn_conv_w[i], ffn_w_down[i])
        new_ffn.append(fb)
        x = layer_norm(ALPHA * x + f, ln_ffn_g[i], ln_ffn_b[i])
        x = x + (p[i].astype(x.dtype) @ ple_w_proj[i]) * jax.nn.sigmoid(x @ ple_w_gate[i])
    return x, jnp.stack(new_dn_conv), jnp.stack(new_dn_S), jnp.stack(new_sc), jnp.stack(new_ffn)


def setup_inputs(seed: int = 0) -> dict:
    key = jax.random.key(seed)
    ks = iter(jax.random.split(key, 40))
    f32 = jnp.float32

    def nrm(shape, scale):
        return jax.random.normal(next(ks), shape, f32) * scale

    x_prompt = nrm((BATCH, SEQ, D_MODEL), 1.0)
    x_sample = nrm((DEC_BATCH, DEC_SEQ, D_MODEL), 1.0)
    p_prompt = nrm((DEPTH, BATCH, SEQ, D_PLE), 1.0)
    p_sample = nrm((DEPTH, DEC_BATCH, DEC_SEQ, D_PLE), 1.0)
    state_dn_conv = nrm((N_A, DEC_BATCH, DN_CONV - 1, QKV_DIM), 1.0)
    state_dn_S = nrm((N_A, DEC_BATCH, H_DN, DK, DV), 0.05)
    state_sc_conv = nrm((N_B, DEC_BATCH, SC_CONV - 1, D_MODEL), 1.0)
    state_ffn_conv = nrm((DEPTH, DEC_BATCH, FFN_CONV - 1, 2 * D_FF), 1.0)

    dn_w_in = nrm((N_A, D_MODEL, A_IN_DIM), D_MODEL ** -0.5)
    dn_conv_w = nrm((N_A, DN_CONV, QKV_DIM), DN_CONV ** -0.5)
    dn_a_log = jnp.log(jax.random.uniform(next(ks), (N_A, H_DN), f32, 1.0, 16.0))
    dt = jnp.exp(jax.random.uniform(next(ks), (N_A, H_DN), f32, math.log(1e-3), math.log(1e-1)))
    dn_dt_bias = dt + jnp.log(-jnp.expm1(-dt))
    dn_norm_g = 1.0 + nrm((N_A, DV), 0.02)
    dn_w_out = nrm((N_A, H_DN * DV, D_MODEL), (H_DN * DV) ** -0.5 * BETA_INIT)

    sc_w_in = nrm((N_B, D_MODEL, 3 * D_MODEL), D_MODEL ** -0.5)
    sc_conv_w = nrm((N_B, SC_CONV, D_MODEL), SC_CONV ** -0.5)
    sc_w_out = nrm((N_B, D_MODEL, D_MODEL), D_MODEL ** -0.5 * BETA_INIT)

    ffn_w_up = nrm((DEPTH, D_MODEL, 2 * D_FF), D_MODEL ** -0.5)
    ffn_conv_w = nrm((DEPTH, FFN_CONV, 2 * D_FF), FFN_CONV ** -0.5)
    ffn_w_down = nrm((DEPTH, D_FF, D_MODEL), D_FF ** -0.5 * BETA_INIT)

    ln_mix_g = 1.0 + nrm((DEPTH, D_MODEL), 0.02)
    ln_mix_b = nrm((DEPTH, D_MODEL), 0.02)
    ln_ffn_g = 1.0 + nrm((DEPTH, D_MODEL), 0.02)
    ln_ffn_b = nrm((DEPTH, D_MODEL), 0.02)
    ple_w_proj = nrm((DEPTH, D_PLE, D_MODEL), D_PLE ** -0.5)
    ple_w_gate = nrm((DEPTH, D_MODEL, D_MODEL), D_MODEL ** -0.5)

    return {'x_prompt': x_prompt, 'x_sample': x_sample, 'p_prompt': p_prompt, 'p_sample': p_sample,
            'state_dn_conv': state_dn_conv, 'state_dn_S': state_dn_S,
            'state_sc_conv': state_sc_conv, 'state_ffn_conv': state_ffn_conv,
            'dn_w_in': dn_w_in, 'dn_conv_w': dn_conv_w, 'dn_a_log': dn_a_log, 'dn_dt_bias': dn_dt_bias,
            'dn_norm_g': dn_norm_g, 'dn_w_out': dn_w_out,
            'sc_w_in': sc_w_in, 'sc_conv_w': sc_conv_w, 'sc_w_out': sc_w_out,
            'ffn_w_up': ffn_w_up, 'ffn_conv_w': ffn_conv_w, 'ffn_w_down': ffn_w_down,
            'ln_mix_g': ln_mix_g, 'ln_mix_b': ln_mix_b, 'ln_ffn_g': ln_ffn_g, 'ln_ffn_b': ln_ffn_b,
            'ple_w_proj': ple_w_proj, 'ple_w_gate': ple_w_gate}


def reference(x_prompt, x_sample, p_prompt, p_sample, state_dn_conv, state_dn_S, state_sc_conv, state_ffn_conv,
              dn_w_in, dn_conv_w, dn_a_log, dn_dt_bias, dn_norm_g, dn_w_out,
              sc_w_in, sc_conv_w, sc_w_out, ffn_w_up, ffn_conv_w, ffn_w_down,
              ln_mix_g, ln_mix_b, ln_ffn_g, ln_ffn_b, ple_w_proj, ple_w_gate):
    Bp = x_prompt.shape[0]
    dt_act = x_prompt.dtype
    z_dn_conv = jnp.zeros((N_A, Bp, DN_CONV - 1, QKV_DIM), dt_act)
    z_dn_S = jnp.zeros((N_A, Bp, H_DN, DK, DV), state_dn_S.dtype)
    z_sc_conv = jnp.zeros((N_B, Bp, SC_CONV - 1, D_MODEL), dt_act)
    z_ffn_conv = jnp.zeros((DEPTH, Bp, FFN_CONV - 1, 2 * D_FF), dt_act)

    y_prompt, prompt_dn_conv, prompt_dn_S, prompt_sc_conv, prompt_ffn_conv = trunk(
        x_prompt, p_prompt, z_dn_conv, z_dn_S, z_sc_conv, z_ffn_conv,
        dn_w_in, dn_conv_w, dn_a_log, dn_dt_bias, dn_norm_g, dn_w_out,
        sc_w_in, sc_conv_w, sc_w_out, ffn_w_up, ffn_conv_w, ffn_w_down,
        ln_mix_g, ln_mix_b, ln_ffn_g, ln_ffn_b, ple_w_proj, ple_w_gate)

    y_sample, sample_dn_conv, sample_dn_S, sample_sc_conv, sample_ffn_conv = trunk(
        x_sample, p_sample, state_dn_conv, state_dn_S, state_sc_conv, state_ffn_conv,
        dn_w_in, dn_conv_w, dn_a_log, dn_dt_bias, dn_norm_g, dn_w_out,
        sc_w_in, sc_conv_w, sc_w_out, ffn_w_up, ffn_conv_w, ffn_w_down,
        ln_mix_g, ln_mix_b, ln_ffn_g, ln_ffn_b, ple_w_proj, ple_w_gate)

    return (y_prompt, y_sample,
            prompt_dn_conv, prompt_dn_S, prompt_sc_conv, prompt_ffn_conv,
            sample_dn_conv, sample_dn_S, sample_sc_conv, sample_ffn_conv)
```

```cpp
#include <hip/hip_runtime.h>
#include <cstdio>
#include <cstdint>

#ifndef MK_PER_PHASE_LAUNCH
#define MK_PER_PHASE_LAUNCH 1
#endif

#define LAS __attribute__((address_space(3)))
#define GAS __attribute__((address_space(1)))
typedef unsigned short bf16_t;
typedef short bf16x8 __attribute__((ext_vector_type(8)));
typedef float f32x4 __attribute__((ext_vector_type(4)));
typedef float f32x2 __attribute__((ext_vector_type(2)));
typedef unsigned u32x4 __attribute__((ext_vector_type(4)));
typedef unsigned u32x2 __attribute__((ext_vector_type(2)));

constexpr int D = 1024, M_P = 16384, M_S = 1024, M = M_P + M_S, SEQ = 2048, DSEQ = 8, NB_P = 8, NB_S = 128;
constexpr int NH = 8, HD = 128, QKV = 3072, AIN = 4112, PROJW = 4096, DFF = 2816, DFF2 = 5632, DPLE = 256, DEPTH = 4;
constexpr float ALPHA = 1.6817928305074290f;
constexpr float LN_EPS = 1e-5f, RMS_EPS = 1e-6f, L2_EPS = 1e-6f;
constexpr float QSCALE = 0.08838834764831845f;

constexpr size_t O_Y = 0, O_PDNC = 17825792, O_PDNS = O_PDNC + 147456, O_PSC = O_PDNS + 2097152, O_PFFN = O_PSC + 32768,
                 O_SDNC = O_PFFN + 360448, O_SDNS = O_SDNC + 2359296, O_SSC = O_SDNS + 33554432, O_SFFN = O_SSC + 524288, O_END = O_SFFN + 5767168;

constexpr size_t WL_IN = 0, WL_OUT = WL_IN + (size_t)4352 * 1024, WL_UP = WL_OUT + (size_t)1024 * 1024, WL_DOWN = WL_UP + (size_t)DFF2 * 1024,
                 WL_G = WL_DOWN + (size_t)1024 * DFF, WL_P = WL_G + (size_t)1024 * 1024, WL_SIZE = WL_P + (size_t)1024 * 256;
constexpr size_t MiB = 1u << 20;
constexpr size_t WS_CTL = 0, CTL_ZERO_BYTES = 1 * MiB;
constexpr size_t WS_VEC = 1 * MiB;
constexpr size_t VEC_L = 2 * DFF2 + 2 * 1024;
constexpr size_t WS_BA = 2 * MiB;
constexpr size_t WS_GATES = WS_BA + (size_t)M * 16 * 4 + 65536;
constexpr size_t WS_ST1 = 5 * MiB, WS_ST2 = 8 * MiB;
constexpr size_t WS_W23 = 11 * MiB;
constexpr size_t WS_X0 = WS_W23 + 2 * WL_SIZE * 2;
constexpr size_t WS_X1 = WS_X0 + (size_t)M * D * 2;
constexpr size_t WS_PB = WS_X1 + (size_t)M * D * 2;
constexpr size_t WS_R1 = WS_PB + (size_t)4 * M * DPLE * 2;
constexpr size_t WS_R2 = WS_R1 + (size_t)M * PROJW * 2;
constexpr size_t WS_END = WS_R2 + (size_t)M * DFF2 * 2;
static_assert(WS_END <= (size_t)520 * MiB, "workspace budget");
constexpr size_t R2_Q = 0, R2_K = (size_t)M * D * 2, R2_V = 2 * R2_K, R2_O = 3 * R2_K;

__device__ __forceinline__ float bf2f(unsigned b) { return __uint_as_float(b << 16); }
__device__ __forceinline__ unsigned f2bf(float f) { unsigned u = __float_as_uint(f); return (u + 0x7fffu + ((u >> 16) & 1u)) >> 16; }
__device__ __forceinline__ unsigned pk2(float lo, float hi) { return f2bf(lo) | (f2bf(hi) << 16); }
__device__ __forceinline__ float sigmoidf_(float x) { return 1.0f / (1.0f + __expf(-x)); }
__device__ __forceinline__ float siluf_(float x) { return x / (1.0f + __expf(-x)); }
__device__ __forceinline__ void unpack8(const u32x4 w, float (&f)[8]) {
    f[0] = __uint_as_float(w.x << 16); f[1] = __uint_as_float(w.x & 0xffff0000u); f[2] = __uint_as_float(w.y << 16); f[3] = __uint_as_float(w.y & 0xffff0000u);
    f[4] = __uint_as_float(w.z << 16); f[5] = __uint_as_float(w.z & 0xffff0000u); f[6] = __uint_as_float(w.w << 16); f[7] = __uint_as_float(w.w & 0xffff0000u);
}
__device__ __forceinline__ u32x4 pack8(const float (&f)[8]) { u32x4 w; w.x = pk2(f[0], f[1]); w.y = pk2(f[2], f[3]); w.z = pk2(f[4], f[5]); w.w = pk2(f[6], f[7]); return w; }
__device__ __forceinline__ float wave_sum(float v) {
#pragma unroll
    for (int o = 1; o < 64; o <<= 1) v += __shfl_xor(v, o);
    return v;
}
__device__ __forceinline__ void row_info(int r, int& b, int& t, int& L, bool& smp) {
    if (r < M_P) { b = r >> 11; t = r & 2047; L = SEQ; smp = false; } else { const int q = r - M_P; b = q >> 3; t = q & 7; L = DSEQ; smp = true; }
}

namespace pg8 {
constexpr int BM = 256, BK = 64, HALF = 128, HTB = HALF * BK * 2, STAGE_BYTES = 8 * HTB, NXCD = 8, WGM = 8;
__host__ __device__ __forceinline__ int lds_byte(int r, int c) { const int st = (r >> 4) * 2 + (c >> 5), rr = r & 15, cc = c & 31, ob = rr * 64 + cc * 2; return st * 1024 + (ob ^ (((ob >> 9) & 1) << 5)); }
__host__ __device__ __forceinline__ void stage_rc(int b, int& R, int& C) { const int st = b / 1024, sb = b % 1024, swz = sb ^ (((sb >> 9) & 1) << 5); R = (st >> 1) * 16 + swz / 64; C = (st & 1) * 32 + (swz % 64) / 2; }
__host__ __device__ __forceinline__ int perm32(int rho) { const int n = rho >> 4, i = rho & 15; return 8 * (i >> 2) + 4 * n + (i & 3); }

struct Unit { int pm, pn; };
struct Gemm { const bf16_t* A; const bf16_t* Bt; int M, N, K, lda; };

struct StaticOrder {
    int nM, nN, nwg, G, c;
    __host__ __device__ void init(int M_, int N_, int G_, int c_) { nM = M_ / BM; nN = N_ / BM; nwg = nM * nN; G = G_; c = c_; }
    __host__ __device__ bool next(int i, Unit& u) const {
        const long L = (long)i * G + c; if (L >= nwg) return false;
        int wgid = (int)L; { const int q = nwg / NXCD, r = nwg % NXCD, xcd = wgid % NXCD, off = wgid / NXCD; wgid = (xcd < r ? xcd * (q + 1) : r * (q + 1) + (xcd - r) * q) + off; }
        const int nig = WGM * nN, gid = wgid / nig, fm = gid * WGM, gsz = (nM - fm) < WGM ? (nM - fm) : WGM;
        u.pm = fm + ((wgid % nig) % gsz); u.pn = (wgid % nig) / gsz; return true;
    }
    __device__ __forceinline__ void a_ready(const Unit&) const {}
    __device__ __forceinline__ void done(const Unit&) const {}
};

typedef f32x4 Acc[2][2][4][2];

__device__ __forceinline__ void row_stats(const float* st  , int row, int fq, float& mu, float& rstd) {
    const f32x4* p = (const f32x4*)(st + (size_t)row * 32 + 8 * fq);
    const f32x4 a = p[0], b = p[1];
    float s = (a.x + a.z) + (b.x + b.z), q = (a.y + a.w) + (b.y + b.w);
    s += __shfl_xor(s, 16); s += __shfl_xor(s, 32); q += __shfl_xor(q, 16); q += __shfl_xor(q, 32);
    mu = s * (1.0f / 1024.0f); const float var = fmaxf(q * (1.0f / 1024.0f) - mu * mu, 0.f); rstd = rsqrtf(var + LN_EPS);
}

struct EpiBf16 {
    static constexpr bool PERM = true;
    bf16_t* O; int ldc; float* ba; int ba_pn;
    __device__ __forceinline__ void operator()(const Acc& acc, const Unit& u, int wr, int wc, int fr, int fq) const {
        const int row0 = u.pm * BM + wr * 64 + fr;
        if (u.pn == ba_pn) {
            if (wc == 0 && fq < 2) {
#pragma unroll
                for (int ai = 0; ai < 2; ++ai)
#pragma unroll
                    for (int m = 0; m < 4; ++m) { float* p = ba + (size_t)(row0 + ai * HALF + m * 16) * 16 + 8 * fq; *(f32x4*)p = acc[ai][0][m][0]; *(f32x4*)(p + 4) = acc[ai][0][m][1]; }
            }
            return;
        }
        const int col0 = u.pn * BM + wc * 32 + 8 * fq;
#pragma unroll
        for (int ai = 0; ai < 2; ++ai)
#pragma unroll
            for (int m = 0; m < 4; ++m) { bf16_t* rowp = O + (size_t)(row0 + ai * HALF + m * 16) * ldc + col0;
#pragma unroll
                for (int bj = 0; bj < 2; ++bj) { const f32x4 v0 = acc[ai][bj][m][0], v1 = acc[ai][bj][m][1];
                    u32x4 w; w.x = pk2(v0[0], v0[1]); w.y = pk2(v0[2], v0[3]); w.z = pk2(v1[0], v1[1]); w.w = pk2(v1[2], v1[3]);
                    *(u32x4*)(rowp + bj * HALF) = w; } }
    }
};
struct EpiResStats {
    static constexpr bool PERM = true;
    bf16_t* X; float* st;
    __device__ __forceinline__ void operator()(const Acc& acc, const Unit& u, int wr, int wc, int fr, int fq) const {
        const int row0 = u.pm * BM + wr * 64 + fr, col0 = u.pn * BM + wc * 32 + 8 * fq;
#pragma unroll
        for (int ai = 0; ai < 2; ++ai)
#pragma unroll
            for (int m = 0; m < 4; ++m) { const int row = row0 + ai * HALF + m * 16; bf16_t* rowp = X + (size_t)row * D + col0; float s = 0.f, q = 0.f;
#pragma unroll
                for (int bj = 0; bj < 2; ++bj) { float x[8]; unpack8(*(const u32x4*)(rowp + bj * HALF), x); const f32x4 v0 = acc[ai][bj][m][0], v1 = acc[ai][bj][m][1];
#pragma unroll
                    for (int e = 0; e < 4; ++e) { x[e] = ALPHA * x[e] + v0[e]; x[4 + e] = ALPHA * x[4 + e] + v1[e]; }
#pragma unroll
                    for (int e = 0; e < 8; ++e) { s += x[e]; q += x[e] * x[e]; }
                    *(u32x4*)(rowp + bj * HALF) = pack8(x); }
                s += __shfl_xor(s, 16); s += __shfl_xor(s, 32); q += __shfl_xor(q, 16); q += __shfl_xor(q, 32);
                if (fq == 0) *(f32x2*)(st + ((size_t)row * 16 + u.pn * 4 + wc) * 2) = (f32x2){s, q}; }
    }
};
struct EpiLnResStats {
    static constexpr bool PERM = true;
    bf16_t* X; const float* st_in; float* st_out; const float* g; const float* b;
    __device__ __forceinline__ void operator()(const Acc& acc, const Unit& u, int wr, int wc, int fr, int fq) const {
        const int row0 = u.pm * BM + wr * 64 + fr, col0 = u.pn * BM + wc * 32 + 8 * fq;
        f32x4 gv[2][2], bv[2][2];
#pragma unroll
        for (int bj = 0; bj < 2; ++bj)
#pragma unroll
            for (int n = 0; n < 2; ++n) { gv[bj][n] = *(const f32x4*)(g + col0 + bj * HALF + 4 * n); bv[bj][n] = *(const f32x4*)(b + col0 + bj * HALF + 4 * n); }
#pragma unroll
        for (int ai = 0; ai < 2; ++ai)
#pragma unroll
            for (int m = 0; m < 4; ++m) { const int row = row0 + ai * HALF + m * 16; bf16_t* rowp = X + (size_t)row * D + col0; float s = 0.f, q = 0.f;
                float mu, rs; row_stats(st_in, row, fq, mu, rs);
#pragma unroll
                for (int bj = 0; bj < 2; ++bj) { float x[8]; unpack8(*(const u32x4*)(rowp + bj * HALF), x); const f32x4 v0 = acc[ai][bj][m][0], v1 = acc[ai][bj][m][1];
#pragma unroll
                    for (int e = 0; e < 4; ++e) { x[e] = ALPHA * ((x[e] - mu) * rs * gv[bj][0][e] + bv[bj][0][e]) + v0[e]; x[4 + e] = ALPHA * ((x[4 + e] - mu) * rs * gv[bj][1][e] + bv[bj][1][e]) + v1[e]; }
#pragma unroll
                    for (int e = 0; e < 8; ++e) { s += x[e]; q += x[e] * x[e]; }
                    *(u32x4*)(rowp + bj * HALF) = pack8(x); }
                s += __shfl_xor(s, 16); s += __shfl_xor(s, 32); q += __shfl_xor(q, 16); q += __shfl_xor(q, 32);
                if (fq == 0) *(f32x2*)(st_out + ((size_t)row * 16 + u.pn * 4 + wc) * 2) = (f32x2){s, q}; }
    }
};
struct EpiLnFold {
    static constexpr bool PERM = true;
    bf16_t* O; int ldc; const float* st; const float* c1; const float* c2;
    __device__ __forceinline__ void operator()(const Acc& acc, const Unit& u, int wr, int wc, int fr, int fq) const {
        const int row0 = u.pm * BM + wr * 64 + fr, col0 = u.pn * BM + wc * 32 + 8 * fq;
        f32x4 c1v[2][2], c2v[2][2];
#pragma unroll
        for (int bj = 0; bj < 2; ++bj)
#pragma unroll
            for (int n = 0; n < 2; ++n) { c1v[bj][n] = *(const f32x4*)(c1 + col0 + bj * HALF + 4 * n); c2v[bj][n] = *(const f32x4*)(c2 + col0 + bj * HALF + 4 * n); }
#pragma unroll
        for (int ai = 0; ai < 2; ++ai)
#pragma unroll
            for (int m = 0; m < 4; ++m) { const int row = row0 + ai * HALF + m * 16; bf16_t* rowp = O + (size_t)row * ldc + col0;
                float mu, rs; row_stats(st, row, fq, mu, rs);
#pragma unroll
                for (int bj = 0; bj < 2; ++bj) { const f32x4 v0 = (acc[ai][bj][m][0] - mu * c1v[bj][0]) * rs + c2v[bj][0], v1 = (acc[ai][bj][m][1] - mu * c1v[bj][1]) * rs + c2v[bj][1];
                    u32x4 w; w.x = pk2(v0[0], v0[1]); w.y = pk2(v0[2], v0[3]); w.z = pk2(v1[0], v1[1]); w.w = pk2(v1[2], v1[3]);
                    *(u32x4*)(rowp + bj * HALF) = w; } }
    }
};
struct EpiGate {
    static constexpr bool PERM = true;
    const bf16_t* H; const bf16_t* PP; bf16_t* XO; float* Y; const float* st; const float* c1; const float* c2; const float* g; const float* b;
    __device__ __forceinline__ void operator()(const Acc& acc, const Unit& u, int wr, int wc, int fr, int fq) const {
        const int row0 = u.pm * BM + wr * 64 + fr, col0 = u.pn * BM + wc * 32 + 8 * fq;
#pragma unroll
        for (int ai = 0; ai < 2; ++ai)
#pragma unroll
            for (int m = 0; m < 4; ++m) { const int row = row0 + ai * HALF + m * 16; const size_t off = (size_t)row * D + col0;
                float mu, rs; row_stats(st, row, fq, mu, rs);
#pragma unroll
                for (int bj = 0; bj < 2; ++bj) { float h[8], pp[8], o[8]; unpack8(*(const u32x4*)(H + off + bj * HALF), h); unpack8(*(const u32x4*)(PP + off + bj * HALF), pp);
#pragma unroll
                    for (int n = 0; n < 2; ++n) { const int cc = col0 + bj * HALF + 4 * n; const f32x4 c1v = *(const f32x4*)(c1 + cc), c2v = *(const f32x4*)(c2 + cc), gv = *(const f32x4*)(g + cc), bv = *(const f32x4*)(b + cc);
#pragma unroll
                        for (int e = 0; e < 4; ++e) { const float gate = (acc[ai][bj][m][n][e] - mu * c1v[e]) * rs + c2v[e]; const float x2 = (h[4 * n + e] - mu) * rs * gv[e] + bv[e];
                            o[4 * n + e] = x2 + pp[4 * n + e] * sigmoidf_(gate); } }
                    *(u32x4*)(XO + off + bj * HALF) = pack8(o);
                    if (Y) { *(f32x4*)(Y + off + bj * HALF) = (f32x4){o[0], o[1], o[2], o[3]}; *(f32x4*)(Y + off + bj * HALF + 4) = (f32x4){o[4], o[5], o[6], o[7]}; } } }
    }
};

template <class Epi, class Sched, bool ALIGN_EPI = true>
__device__ __forceinline__ void gemm_phase(LAS unsigned char* lds, const int tid, const Gemm g, const Sched& S, const Epi& E) {
    const int wid = __builtin_amdgcn_readfirstlane(tid >> 6), lane = tid & 63, wr = wid >> 2, wc = wid & 3, fr = lane & 15, fq = lane >> 4;
    const int K = g.K, nt = K / BK, lda = g.lda;
    unsigned voffA[2], voffB[2];
#pragma unroll
    for (int i = 0; i < 2; ++i) { int R, C; stage_rc(tid * 16 + i * 8192, R, C); const int Rb = Epi::PERM ? ((R & ~31) + perm32(R & 31)) : R;
        voffA[i] = (unsigned)(R * lda + C) * 2u; voffB[i] = (unsigned)(Rb * K + C) * 2u; }
    const size_t kstep = (size_t)(BK * 2);
    const size_t hstepA = (size_t)HALF * lda * 2, hstepB = (size_t)HALF * K * 2;
    const size_t tstepA = 2 * hstepA, tstepB = 2 * hstepB;
    const unsigned ldsw = (unsigned)wid * 1024u;
    const int aoff = lds_byte(wr * 64 + fr, fq * 8), boff = lds_byte(wc * 32 + fr, fq * 8);
#define PG8_SA(b, h) (((b) * 2 + (h)) * HTB)
#define PG8_SB(b, h) ((4 + (b) * 2 + (h)) * HTB)
#define PG8_STAGE(bufoff, gbase, voff) do { _Pragma("unroll") for (int _i = 0; _i < 2; ++_i) \
        __builtin_amdgcn_global_load_lds((const unsigned*)((const char*)(gbase) + (voff)[_i]), (LAS unsigned*)(lds + (bufoff) + ldsw + _i * 8192), 16, 0, 0); } while (0)
#define PG8_LDA(dst, b, h) do { _Pragma("unroll") for (int m = 0; m < 4; ++m) _Pragma("unroll") for (int k = 0; k < 2; ++k) dst[m][k] = *(const LAS bf16x8*)(lds + PG8_SA(b, h) + aoff + m * 2048 + k * 1024); } while (0)
#define PG8_LDB(dst, b, h) do { _Pragma("unroll") for (int n = 0; n < 2; ++n) _Pragma("unroll") for (int k = 0; k < 2; ++k) dst[n][k] = *(const LAS bf16x8*)(lds + PG8_SB(b, h) + boff + n * 2048 + k * 1024); } while (0)
#define PG8_MMA(ai, bj, At, Bt) do { __builtin_amdgcn_s_setprio(1); _Pragma("unroll") for (int m = 0; m < 4; ++m) _Pragma("unroll") for (int n = 0; n < 2; ++n) _Pragma("unroll") for (int k = 0; k < 2; ++k) \
        acc[ai][bj][m][n] = __builtin_amdgcn_mfma_f32_16x16x32_bf16(Bt[n][k], At[m][k], acc[ai][bj][m][n], 0, 0, 0); __builtin_amdgcn_s_setprio(0); } while (0)
#define PG8_WAIT_V(n) asm volatile("s_waitcnt vmcnt(" #n ")" ::: "memory")
#define PG8_WAIT_L(n) asm volatile("s_waitcnt lgkmcnt(" #n ")" ::: "memory")
#define PG8_BAR __builtin_amdgcn_s_barrier()
#define PG8_SCHED __builtin_amdgcn_sched_barrier(0)
    Unit cur, nxt; int ui = 0;
    if (!S.next(0, cur)) return;
    f32x4 acc[2][2][4][2];
#pragma unroll
    for (int a = 0; a < 2; ++a)
#pragma unroll
        for (int b = 0; b < 2; ++b)
#pragma unroll
            for (int m = 0; m < 4; ++m)
#pragma unroll
                for (int n = 0; n < 2; ++n) acc[a][b][m][n] = (f32x4){0.f, 0.f, 0.f, 0.f};
    bf16x8 At[4][2], B0[2][2], B1[2][2];
    const char* cA = (const char*)g.A + (size_t)cur.pm * tstepA; const char* cB = (const char*)g.Bt + (size_t)cur.pn * tstepB;
    S.a_ready(cur);
    PG8_STAGE(PG8_SB(0, 0), cB, voffB); PG8_STAGE(PG8_SB(0, 1), cB + hstepB, voffB); PG8_STAGE(PG8_SA(0, 0), cA, voffA); PG8_STAGE(PG8_SA(0, 1), cA + hstepA, voffA);
    if (wr == 1) PG8_BAR;
    PG8_WAIT_V(2); PG8_BAR;
    PG8_STAGE(PG8_SB(1, 0), cB + kstep, voffB); PG8_STAGE(PG8_SA(1, 0), cA + kstep, voffA); PG8_STAGE(PG8_SB(1, 1), cB + hstepB + kstep, voffB);
    PG8_WAIT_V(6); PG8_BAR;
    for (;;) {
        const bool has_next = S.next(ui + 1, nxt);
        const char* nA = has_next ? (const char*)g.A + (size_t)nxt.pm * tstepA : cA; const char* nB = has_next ? (const char*)g.Bt + (size_t)nxt.pn * tstepB : cB;
        for (int t = 0; t < nt; t += 2) {
            const bool last = (t == nt - 2);
            const char* a1 = cA + (size_t)(t + 1) * kstep;
            const char* a2 = last ? nA : cA + (size_t)(t + 2) * kstep; const char* b2 = last ? nB : cB + (size_t)(t + 2) * kstep;
            const char* a3 = a2 + kstep; const char* b3 = b2 + kstep;
            if (last && has_next) S.a_ready(nxt);
            PG8_LDB(B0, 0, 0); PG8_LDB(B1, 0, 1); PG8_SCHED; PG8_LDA(At, 0, 0); PG8_STAGE(PG8_SA(1, 1), a1 + hstepA, voffA);
            PG8_WAIT_V(8); PG8_WAIT_L(0); PG8_BAR; PG8_MMA(0, 0, At, B0); PG8_MMA(0, 1, At, B1); PG8_BAR; PG8_SCHED;
            PG8_LDA(At, 0, 1); PG8_STAGE(PG8_SB(0, 0), b2, voffB); PG8_STAGE(PG8_SB(0, 1), b2 + hstepB, voffB); PG8_STAGE(PG8_SA(0, 0), a2, voffA);
            PG8_WAIT_V(8); PG8_WAIT_L(0); PG8_BAR; PG8_MMA(1, 0, At, B0); PG8_MMA(1, 1, At, B1); PG8_BAR; PG8_SCHED;
            PG8_LDB(B0, 1, 0); PG8_LDB(B1, 1, 1); PG8_SCHED; PG8_LDA(At, 1, 0); PG8_STAGE(PG8_SA(0, 1), a2 + hstepA, voffA);
            PG8_WAIT_V(8); PG8_WAIT_L(0); PG8_BAR; PG8_MMA(0, 0, At, B0); PG8_MMA(0, 1, At, B1); PG8_BAR; PG8_SCHED;
            PG8_LDA(At, 1, 1); PG8_STAGE(PG8_SB(1, 0), b3, voffB); PG8_STAGE(PG8_SB(1, 1), b3 + hstepB, voffB); PG8_STAGE(PG8_SA(1, 0), a3, voffA);
            PG8_WAIT_V(8); PG8_WAIT_L(0); PG8_BAR; PG8_MMA(1, 0, At, B0); PG8_MMA(1, 1, At, B1); PG8_BAR; PG8_SCHED;
        }
        if constexpr (ALIGN_EPI) { if (wr == 0) PG8_BAR; }
        E(acc, cur, wr, wc, fr, fq); S.done(cur);
        if (!has_next) break;
#pragma unroll
        for (int a = 0; a < 2; ++a)
#pragma unroll
            for (int b = 0; b < 2; ++b)
#pragma unroll
                for (int m = 0; m < 4; ++m)
#pragma unroll
                    for (int n = 0; n < 2; ++n) acc[a][b][m][n] = (f32x4){0.f, 0.f, 0.f, 0.f};
        cur = nxt; cA = nA; cB = nB; ++ui;
        if constexpr (ALIGN_EPI) { if (wr == 1) PG8_BAR; }
    }
    PG8_WAIT_V(0);
    if constexpr (!ALIGN_EPI) { if (wr == 0) PG8_BAR; }
    PG8_BAR;
#undef PG8_SA
#undef PG8_SB
#undef PG8_STAGE
#undef PG8_LDA
#undef PG8_LDB
#undef PG8_MMA
#undef PG8_WAIT_V
#undef PG8_WAIT_L
#undef PG8_BAR
#undef PG8_SCHED
}
}

constexpr int NWAVES = 8, NTHR = NWAVES * 64;
constexpr int RING_BYTES = 131072, LDSCTL_OFF = RING_BYTES, MISC_OFF = LDSCTL_OFF + 320, LDS_BYTES = 147456;
typedef GAS unsigned gu32;
#define RLX_AGENT __ATOMIC_RELAXED, __HIP_MEMORY_SCOPE_AGENT

#define XB_TMO      128
#define XB_XCNT(j)  (256  + 64 * (j))
#define XB_XSUB(j)  (1280 + 64 * (j))
#define XB_XGEN(j)  (2304 + 64 * (j))
#define XB_TOP      3328
#define XB_TOPGEN   3392
#define XCD_BAR_WORDS 3456
#define XB_SPIN_CAP (1u << 18)
constexpr int CW_BAR = 4096;
__device__ __forceinline__ unsigned xb_ld(unsigned* p)              { return __hip_atomic_load(p, __ATOMIC_RELAXED, __HIP_MEMORY_SCOPE_AGENT); }
__device__ __forceinline__ unsigned xb_add(unsigned* p, unsigned v) { return __hip_atomic_fetch_add(p, v, __ATOMIC_RELAXED, __HIP_MEMORY_SCOPE_AGENT); }
__device__ __forceinline__ unsigned xb_xcc_id() { return (unsigned)__builtin_amdgcn_s_getreg((3 << 11) | 20) & 0xFu; }
#define XB_SPIN(cond, bar) do { unsigned _sp = 0; while (cond) { __builtin_amdgcn_s_sleep(1); \
    if ((++_sp & 255u) == 0u) { if (xb_ld(&(bar)[XB_TMO])) break; if (_sp > XB_SPIN_CAP) { atomicAdd(&(bar)[XB_TMO], 1u); break; } } } } while (0)
struct XcdBarrier { unsigned* bar; unsigned x; volatile LAS unsigned* st; };
__device__ __forceinline__ XcdBarrier xcd_barrier_post(unsigned* bar, volatile LAS unsigned* st) {
    XcdBarrier b; b.bar = bar; b.x = xb_xcc_id(); b.st = st;
    if (threadIdx.x == 0) (void)xb_add(&bar[XB_XCNT(b.x)], 1u);
    return b;
}
__device__ __forceinline__ void xcd_barrier_complete(unsigned* bar, unsigned x, unsigned& nloc, unsigned& nx) {
    const unsigned G = gridDim.x * gridDim.y * gridDim.z;
    unsigned sum, cnt, mine, sp = 0u;
    for (;;) {
        sum = 0u; cnt = 0u; mine = 0u;
#pragma unroll
        for (unsigned j = 0; j < 16; ++j) { const unsigned c = xb_ld(&bar[XB_XCNT(j)]); sum += c; cnt += (c > 0u) ? 1u : 0u; mine = (j == x) ? c : mine; }
        if (sum == G) break;
        __builtin_amdgcn_s_sleep(1);
        if ((++sp & 255u) == 0u) { if (xb_ld(&bar[XB_TMO])) break; if (sp > XB_SPIN_CAP) { atomicAdd(&bar[XB_TMO], 1u); break; } }
    }
    nloc = mine > 0u ? mine : 1u; nx = cnt > 0u ? cnt : 1u;
}
__device__ __forceinline__ void xcd_barrier(const XcdBarrier& b) {
    asm volatile("s_waitcnt vmcnt(0)" ::: "memory");
    __syncthreads();
    if (threadIdx.x == 0) {
        unsigned* bar = b.bar;
        __builtin_amdgcn_s_waitcnt(0);
        unsigned nloc = b.st[0], nx = b.st[1];
        if (nloc == 0u) { xcd_barrier_complete(bar, b.x, nloc, nx); b.st[0] = nloc; b.st[1] = nx; }
        const unsigned old = xb_add(&bar[XB_XSUB(b.x)], 1u);
        const unsigned gen = old / nloc;
        if (old + 1u == (gen + 1u) * nloc) {
            __builtin_amdgcn_fence(__ATOMIC_RELEASE, "agent");
            asm volatile("s_waitcnt vmcnt(0)" ::: "memory");
            const unsigned og = xb_add(&bar[XB_TOP], 1u);
            const unsigned tg = og / nx;
            if (og + 1u == (tg + 1u) * nx) xb_add(&bar[XB_TOPGEN], 1u);
            else XB_SPIN(xb_ld(&bar[XB_TOPGEN]) == tg, bar);
            __builtin_amdgcn_fence(__ATOMIC_ACQUIRE, "agent");
            xb_add(&bar[XB_XGEN(b.x)], 1u);
            asm volatile("s_waitcnt vmcnt(0)" ::: "memory");
        } else {
            XB_SPIN(xb_ld(&bar[XB_XGEN(b.x)]) == gen, bar);
            __builtin_amdgcn_fence(__ATOMIC_ACQUIRE, "agent");
            asm volatile("s_waitcnt vmcnt(0)" ::: "memory");
        }
    }
    __syncthreads();
}

struct Args {
    const float* in[26]; float* out; unsigned char* ws; int ph_lo, ph_hi;
};
struct Frame {
    LAS unsigned char* lds; int tid, lane, wave, vcu, G;
};
typedef const __attribute__((address_space(4))) Args* KArgs;
__device__ __forceinline__ bf16_t* wl_base(KArgs a, int l) {
    return l < 2 ? (bf16_t*)(a->out + O_SDNS + (size_t)NB_S * NH * HD * HD) + (size_t)l * WL_SIZE : (bf16_t*)(a->ws + WS_W23) + (size_t)(l - 2) * WL_SIZE;
}
__device__ __forceinline__ float* vec_base(KArgs a, int l) { return (float*)(a->ws + WS_VEC) + (size_t)l * VEC_L; }

__device__ __forceinline__ void p0_transpose_item(const float* W, int K, int N, int ldn, const float* gk, bf16_t* WT, LAS float* scr, int item, int nblk, int lane) {
    const int kb = item / nblk, nb = item % nblk, k0 = 64 * kb, n0 = 32 * nb;
    const int n = n0 + (lane & 31);
#pragma unroll 8
    for (int i = 0; i < 32; ++i) { const int kk = 2 * i + (lane >> 5); float v = (n < N) ? W[(size_t)(k0 + kk) * ldn + n] : 0.f; if (gk) v *= gk[k0 + kk]; scr[kk * 33 + (lane & 31)] = v; }
    asm volatile("s_waitcnt lgkmcnt(0)" ::: "memory");
    const int c = lane & 7;
#pragma unroll
    for (int j = 0; j < 4; ++j) { const int nn = (lane >> 3) + 8 * j; const LAS float* s = scr + (8 * c) * 33 + nn;
        u32x4 o; o.x = pk2(s[0 * 33], s[1 * 33]); o.y = pk2(s[2 * 33], s[3 * 33]); o.z = pk2(s[4 * 33], s[5 * 33]); o.w = pk2(s[6 * 33], s[7 * 33]);
        *(u32x4*)(WT + (size_t)(n0 + nn) * K + k0 + 8 * c) = o; }
    asm volatile("s_waitcnt lgkmcnt(0)" ::: "memory");
}
__device__ __forceinline__ void p0_transpose(const Frame& F, const float* W, int K, int N, int Npad, const float* gk, bf16_t* WT) {
    LAS float* scr = (LAS float*)(F.lds + F.wave * 16384);
    const int gw = F.vcu * NWAVES + F.wave, NGW = F.G * NWAVES, nblk = Npad / 32, nitems = (K / 64) * nblk;
    for (int it = gw; it < nitems; it += NGW) p0_transpose_item(W, K, N, N, gk, WT, scr, it, nblk, F.lane);
}
__device__ __forceinline__ void p0_prologue(const Frame& F, KArgs a) {
    for (int l = 0; l < DEPTH; ++l) {
        bf16_t* wb = wl_base(a, l); const int j = l >> 1;
        if ((l & 1) == 0) { p0_transpose(F, a->in[8] + (size_t)j * D * AIN, D, AIN, 4352, nullptr, wb + WL_IN); p0_transpose(F, a->in[13] + (size_t)j * D * D, D, D, D, nullptr, wb + WL_OUT); }
        else { p0_transpose(F, a->in[14] + (size_t)j * D * 3 * D, D, 3 * D, 3 * D, nullptr, wb + WL_IN); p0_transpose(F, a->in[16] + (size_t)j * D * D, D, D, D, nullptr, wb + WL_OUT); }
        p0_transpose(F, a->in[17] + (size_t)l * D * DFF2, D, DFF2, DFF2, a->in[20] + l * D, wb + WL_UP);
        p0_transpose(F, a->in[19] + (size_t)l * DFF * D, DFF, D, D, nullptr, wb + WL_DOWN);
        p0_transpose(F, a->in[25] + (size_t)l * D * D, D, D, D, a->in[22] + l * D, wb + WL_G);
        p0_transpose(F, a->in[24] + (size_t)l * DPLE * D, DPLE, D, D, nullptr, wb + WL_P);
    }
    const int gt = F.vcu * NTHR + F.tid, NGT = F.G * NTHR;
    for (int it = gt; it < DEPTH * (DFF2 + D); it += NGT) {
        const int l = it / (DFF2 + D), n0 = it % (DFF2 + D); const bool up = n0 < DFF2; const int n = up ? n0 : n0 - DFF2, N = up ? DFF2 : D;
        const float* W = up ? a->in[17] + (size_t)l * D * DFF2 : a->in[25] + (size_t)l * D * D;
        const float* g = (up ? a->in[20] : a->in[22]) + l * D; const float* b = (up ? a->in[21] : a->in[23]) + l * D;
        float s1 = 0.f, s2 = 0.f;
        for (int k = 0; k < D; ++k) { const float w = W[(size_t)k * N + n]; s1 += bf2f(f2bf(g[k] * w)); s2 += b[k] * w; }
        float* vb = vec_base(a, l); if (up) { vb[n] = s1; vb[DFF2 + n] = s2; } else { vb[2 * DFF2 + n] = s1; vb[2 * DFF2 + D + n] = s2; }
    }
    bf16_t* X0 = (bf16_t*)(a->ws + WS_X0); bf16_t* PB = (bf16_t*)(a->ws + WS_PB);
    for (size_t i = gt; i < (size_t)M * D / 8; i += NGT) { const size_t e = i * 8; const float* src = e < (size_t)M_P * D ? a->in[0] + e : a->in[1] + (e - (size_t)M_P * D);
        const f32x4 v0 = *(const f32x4*)src, v1 = *(const f32x4*)(src + 4); u32x4 w; w.x = pk2(v0[0], v0[1]); w.y = pk2(v0[2], v0[3]); w.z = pk2(v1[0], v1[1]); w.w = pk2(v1[2], v1[3]); *(u32x4*)(X0 + e) = w; }
    for (size_t i = gt; i < (size_t)DEPTH * M * DPLE / 8; i += NGT) { const size_t e = i * 8; const size_t l = e / ((size_t)M * DPLE), r = e % ((size_t)M * DPLE);
        const float* src = r < (size_t)M_P * DPLE ? a->in[2] + l * (size_t)M_P * DPLE + r : a->in[3] + l * (size_t)M_S * DPLE + (r - (size_t)M_P * DPLE);
        const f32x4 v0 = *(const f32x4*)src, v1 = *(const f32x4*)(src + 4); u32x4 w; w.x = pk2(v0[0], v0[1]); w.y = pk2(v0[2], v0[3]); w.z = pk2(v1[0], v1[1]); w.w = pk2(v1[2], v1[3]); *(u32x4*)(PB + e) = w; }
}

__device__ __forceinline__ void dn_pre_phase(const Frame& F, KArgs a, int j) {
    const bf16_t* proj = (const bf16_t*)(a->ws + WS_R1); const float* ba = (const float*)(a->ws + WS_BA);
    bf16_t* Q = (bf16_t*)(a->ws + WS_R2 + R2_Q); bf16_t* Kb = (bf16_t*)(a->ws + WS_R2 + R2_K); bf16_t* V = (bf16_t*)(a->ws + WS_R2 + R2_V);
    float* beta = (float*)(a->ws + WS_GATES); float* gg = beta + (size_t)M * 8;
    const float* cw = a->in[9] + (size_t)j * 4 * QKV; const float* sbuf = a->in[4] + (size_t)j * NB_S * 3 * QKV;
    const int gw = F.vcu * NWAVES + F.wave, NGW = F.G * NWAVES, lane = F.lane;
    for (int it = gw; it < M * NH; it += NGW) {
        const int r = it >> 3, h = it & 7; int b, t, L; bool smp; row_info(r, b, t, L, smp);
        float res[3][2];
#pragma unroll
        for (int part = 0; part < 3; ++part) {
            const int col = part * 1024 + h * HD + 2 * lane; float y0 = 0.f, y1 = 0.f;
#pragma unroll
            for (int jj = 0; jj < 4; ++jj) { const int d = 3 - jj; float u0, u1;
                if (t - d >= 0) { const unsigned w = *(const unsigned*)(proj + (size_t)(r - d) * PROJW + col); u0 = bf2f(w & 0xffffu); u1 = bf2f(w >> 16); }
                else if (smp) { const float* p = sbuf + ((size_t)b * 3 + (t + jj)) * QKV + col; u0 = p[0]; u1 = p[1]; }
                else { u0 = 0.f; u1 = 0.f; }
                const f32x2 wv = *(const f32x2*)(cw + (size_t)jj * QKV + col); y0 += wv.x * u0; y1 += wv.y * u1;
                if (jj == 3 && t >= L - 3) { float* o = a->out + (smp ? O_SDNC : O_PDNC) + (((size_t)j * (smp ? NB_S : NB_P) + b) * 3 + (t - (L - 3))) * QKV + col; o[0] = u0; o[1] = u1; } }
            res[part][0] = siluf_(y0); res[part][1] = siluf_(y1);
        }
        const float sq = wave_sum(res[0][0] * res[0][0] + res[0][1] * res[0][1]), sk = wave_sum(res[1][0] * res[1][0] + res[1][1] * res[1][1]);
        const float rq = rsqrtf(sq + L2_EPS) * QSCALE, rk = rsqrtf(sk + L2_EPS);
        const size_t o = (size_t)r * D + h * HD + 2 * lane;
        *(unsigned*)(Q + o) = pk2(res[0][0] * rq, res[0][1] * rq); *(unsigned*)(Kb + o) = pk2(res[1][0] * rk, res[1][1] * rk); *(unsigned*)(V + o) = pk2(res[2][0], res[2][1]);
        if (lane == 0) { const float b1 = ba[(size_t)r * 16 + h], b2 = ba[(size_t)r * 16 + 8 + h] + a->in[11][j * 8 + h];
            const float sp = b2 > 20.f ? b2 : log1pf(expf(b2));
            beta[(size_t)r * 8 + h] = sigmoidf_(b1); gg[(size_t)r * 8 + h] = -expf(a->in[10][j * 8 + h]) * sp; }
    }
}
__device__ __forceinline__ void dn_scan_naive(const Frame& F, KArgs a, int j) {
    const bf16_t* Q = (const bf16_t*)(a->ws + WS_R2 + R2_Q); const bf16_t* Kb = (const bf16_t*)(a->ws + WS_R2 + R2_K); const bf16_t* V = (const bf16_t*)(a->ws + WS_R2 + R2_V);
    float* O = (float*)(a->ws + WS_R2 + R2_O);
    const float* beta = (const float*)(a->ws + WS_GATES); const float* gg = beta + (size_t)M * 8;
    LAS float* sk = (LAS float*)F.lds;
    LAS float* sq = sk + 32 * 128;
    LAS float* sv = sq + 32 * 128;
    LAS float* sg = sv + 32 * 128;
    LAS float* red = sg + 64;
    LAS float* red2 = red + 2 * 512;
    const int tid = F.tid, v = tid & 127, kq = tid >> 7;
    for (int u = F.vcu; u < NB_P * NH + NB_S * NH; u += F.G) {
        const bool smp = u >= NB_P * NH; const int uu = smp ? u - NB_P * NH : u, b = uu >> 3, h = uu & 7, L = smp ? DSEQ : SEQ;
        const int row0 = smp ? M_P + b * DSEQ : b * SEQ;
        float S[32];
        if (smp) { const float* s0 = a->in[5] + (((size_t)j * NB_S + b) * NH + h) * HD * HD;
#pragma unroll
            for (int i = 0; i < 32; ++i) S[i] = s0[(size_t)(32 * kq + i) * HD + v]; }
        else {
#pragma unroll
            for (int i = 0; i < 32; ++i) S[i] = 0.f; }
        for (int t0 = 0; t0 < L; t0 += 32) {
            const int nt = (L - t0) < 32 ? (L - t0) : 32;
            __syncthreads();
            for (int e = tid; e < nt * 128; e += NTHR) { const int tt = e >> 7, c = e & 127; const size_t o = (size_t)(row0 + t0 + tt) * D + h * HD + c;
                sk[e] = bf2f(Kb[o]); sq[e] = bf2f(Q[o]); sv[e] = bf2f(V[o]); }
            if (tid < nt) { sg[2 * tid] = beta[(size_t)(row0 + t0 + tid) * 8 + h]; sg[2 * tid + 1] = gg[(size_t)(row0 + t0 + tid) * 8 + h]; }
            __syncthreads();
            for (int tt = 0; tt < nt; ++tt) {
                const float bt = sg[2 * tt], dec = __expf(sg[2 * tt + 1]); const int pb = tt & 1;
                float part = 0.f;
#pragma unroll
                for (int i = 0; i < 32; ++i) { S[i] *= dec; part += S[i] * sk[tt * 128 + 32 * kq + i]; }
                red[(pb * 4 + kq) * 128 + v] = part;
                __syncthreads();
                const float kS = (red[(pb * 4 + 0) * 128 + v] + red[(pb * 4 + 1) * 128 + v]) + (red[(pb * 4 + 2) * 128 + v] + red[(pb * 4 + 3) * 128 + v]);
                const float delta = bt * (sv[tt * 128 + v] - kS);
                float op = 0.f;
#pragma unroll
                for (int i = 0; i < 32; ++i) { S[i] += sk[tt * 128 + 32 * kq + i] * delta; op += S[i] * sq[tt * 128 + 32 * kq + i]; }
                red2[(pb * 4 + kq) * 128 + v] = op;
                __syncthreads();
                if (kq == 0) O[(size_t)(row0 + t0 + tt) * D + h * HD + v] = (red2[(pb * 4 + 0) * 128 + v] + red2[(pb * 4 + 1) * 128 + v]) + (red2[(pb * 4 + 2) * 128 + v] + red2[(pb * 4 + 3) * 128 + v]);
            }
        }
        float* so = a->out + (smp ? O_SDNS : O_PDNS) + (((size_t)j * (smp ? NB_S : NB_P) + b) * NH + h) * HD * HD;
#pragma unroll
        for (int i = 0; i < 32; ++i) so[(size_t)(32 * kq + i) * HD + v] = S[i];
    }
}
__device__ __forceinline__ void dn_gate_phase(const Frame& F, KArgs a, int j) {
    bf16_t* proj = (bf16_t*)(a->ws + WS_R1); const float* O = (const float*)(a->ws + WS_R2 + R2_O); const float* ng = a->in[12] + j * HD;
    const int gw = F.vcu * NWAVES + F.wave, NGW = F.G * NWAVES, lane = F.lane;
    const f32x2 nv = *(const f32x2*)(ng + 2 * lane);
    for (int it = gw; it < M * NH; it += NGW) {
        const int r = it >> 3, h = it & 7;
        const f32x2 o = *(const f32x2*)(O + (size_t)r * D + h * HD + 2 * lane);
        const float rs = rsqrtf(wave_sum(o.x * o.x + o.y * o.y) * (1.0f / HD) + RMS_EPS);
        bf16_t* zp = proj + (size_t)r * PROJW + QKV + h * HD + 2 * lane; const unsigned zw = *(const unsigned*)zp;
        *(unsigned*)zp = pk2(o.x * rs * nv.x * siluf_(bf2f(zw & 0xffffu)), o.y * rs * nv.y * siluf_(bf2f(zw >> 16)));
    }
}
__device__ __forceinline__ void sc_act_phase(const Frame& F, KArgs a, int j) {
    bf16_t* proj = (bf16_t*)(a->ws + WS_R1); const float* cw = a->in[15] + (size_t)j * 3 * D; const float* sbuf = a->in[6] + (size_t)j * NB_S * 2 * D;
    const int gw = F.vcu * NWAVES + F.wave, NGW = F.G * NWAVES, lane = F.lane;
    for (int it = gw; it < M * 2; it += NGW) {
        const int r = it >> 1, c0 = (it & 1) * 512 + 8 * lane; int b, t, L; bool smp; row_info(r, b, t, L, smp);
        float y[8];
#pragma unroll
        for (int e = 0; e < 8; ++e) y[e] = 0.f;
#pragma unroll
        for (int jj = 0; jj < 3; ++jj) { const int d = 2 - jj; float u[8];
            if (t - d >= 0) { float cc[8], hh[8]; unpack8(*(const u32x4*)(proj + (size_t)(r - d) * 3072 + 1024 + c0), cc); unpack8(*(const u32x4*)(proj + (size_t)(r - d) * 3072 + 2048 + c0), hh);
#pragma unroll
                for (int e = 0; e < 8; ++e) u[e] = cc[e] * hh[e]; }
            else if (smp) { const float* p = sbuf + ((size_t)b * 2 + (t + jj)) * D + c0;
#pragma unroll
                for (int e = 0; e < 8; ++e) u[e] = p[e]; }
            else {
#pragma unroll
                for (int e = 0; e < 8; ++e) u[e] = 0.f; }
            const float* wp = cw + (size_t)jj * D + c0;
#pragma unroll
            for (int e = 0; e < 8; ++e) y[e] += wp[e] * u[e];
            if (jj == 2 && t >= L - 2) { float* o = a->out + (smp ? O_SSC : O_PSC) + (((size_t)j * (smp ? NB_S : NB_P) + b) * 2 + (t - (L - 2))) * D + c0;
#pragma unroll
                for (int e = 0; e < 8; ++e) o[e] = u[e]; } }
        float bb[8]; bf16_t* bp = proj + (size_t)r * 3072 + c0; unpack8(*(const u32x4*)bp, bb);
#pragma unroll
        for (int e = 0; e < 8; ++e) y[e] *= bb[e];
        *(u32x4*)bp = pack8(y);
    }
}
__device__ __forceinline__ void ffn_act_phase(const Frame& F, KArgs a, int l) {
    const bf16_t* up = (const bf16_t*)(a->ws + WS_R2); bf16_t* act = (bf16_t*)(a->ws + WS_R1);
    const float* cw = a->in[18] + (size_t)l * 3 * DFF2; const float* sbuf = a->in[7] + (size_t)l * NB_S * 2 * DFF2;
    const int gw = F.vcu * NWAVES + F.wave, NGW = F.G * NWAVES, lane = F.lane;
    for (int it = gw; it < M * 6; it += NGW) {
        const int r = it / 6, c0 = (it % 6) * 512 + 8 * lane; if (c0 >= DFF) continue;
        int b, t, L; bool smp; row_info(r, b, t, L, smp);
        float yv[8], yg[8];
#pragma unroll
        for (int e = 0; e < 8; ++e) { yv[e] = 0.f; yg[e] = 0.f; }
#pragma unroll
        for (int jj = 0; jj < 3; ++jj) { const int d = 2 - jj; float uv[8], ug[8];
            if (t - d >= 0) { unpack8(*(const u32x4*)(up + (size_t)(r - d) * DFF2 + c0), uv); unpack8(*(const u32x4*)(up + (size_t)(r - d) * DFF2 + DFF + c0), ug); }
            else if (smp) { const float* p = sbuf + ((size_t)b * 2 + (t + jj)) * DFF2 + c0;
#pragma unroll
                for (int e = 0; e < 8; ++e) { uv[e] = p[e]; ug[e] = p[DFF + e]; } }
            else {
#pragma unroll
                for (int e = 0; e < 8; ++e) { uv[e] = 0.f; ug[e] = 0.f; } }
            const float* wp = cw + (size_t)jj * DFF2 + c0;
#pragma unroll
            for (int e = 0; e < 8; ++e) { yv[e] += wp[e] * uv[e]; yg[e] += wp[DFF + e] * ug[e]; }
            if (jj == 2 && t >= L - 2) { float* o = a->out + (smp ? O_SFFN : O_PFFN) + (((size_t)l * (smp ? NB_S : NB_P) + b) * 2 + (t - (L - 2))) * DFF2 + c0;
#pragma unroll
                for (int e = 0; e < 8; ++e) { o[e] = uv[e]; o[DFF + e] = ug[e]; } } }
#pragma unroll
        for (int e = 0; e < 8; ++e) yv[e] *= siluf_(yg[e]);
        *(u32x4*)(act + (size_t)r * DFF + c0) = pack8(yv);
    }
}

enum Kind { K_P0 = 0, K_PROJ, K_DN_PRE, K_DN_SCAN, K_DN_GATE, K_SC_ACT, K_WOUT, K_UP, K_ACT, K_DOWN, K_GATE };
constexpr int N_PHASES = 1 + 9 + 7 + 9 + 7;
__host__ __device__ __forceinline__ void decode_phase(int p, int& l, int& kind) {
    if (p == 0) { l = 0; kind = K_P0; return; }
    p -= 1; l = 0;
    for (;;) { const int n = (l & 1) ? 7 : 9; if (p < n) break; p -= n; ++l; }
    const unsigned long long dnk = 0xA98764321ull  , sck = 0xA987651ull  ;
    kind = (int)((((l & 1) == 0 ? dnk : sck) >> (4 * p)) & 0xFull);
}

__global__ void __launch_bounds__(NTHR, 2) mk_fwd(Args args) {
    extern __shared__ __attribute__((aligned(16))) unsigned char lds_raw[];
    Frame F; F.lds = (LAS unsigned char*)lds_raw; F.tid = threadIdx.x; F.lane = F.tid & 63; F.wave = __builtin_amdgcn_readfirstlane(F.tid >> 6);
    F.G = gridDim.x; { const int bx = blockIdx.x; F.vcu = (F.G % 8 == 0) ? (bx % 8) * (F.G / 8) + bx / 8 : bx; }
    volatile LAS unsigned* MISC = (volatile LAS unsigned*)(F.lds + MISC_OFF);
    for (int u = F.tid; u < (LDS_BYTES - LDSCTL_OFF) / 4; u += NTHR) ((LAS unsigned*)(F.lds + LDSCTL_OFF))[u] = 0u;
    __syncthreads();
    const int ph_lo = args.ph_lo, ph_hi = args.ph_hi;
    XcdBarrier bar; bar.bar = (unsigned*)(args.ws + WS_CTL) + CW_BAR; bar.x = 0; bar.st = nullptr;
    if (ph_hi - ph_lo > 1) bar = xcd_barrier_post((unsigned*)(args.ws + WS_CTL) + CW_BAR, MISC + 8);
    for (int p = ph_lo; p < ph_hi; ++p) {
        KArgs ka = (KArgs)__builtin_amdgcn_kernarg_segment_ptr(); asm volatile("" : "+s"(ka));
        { int t_ = threadIdx.x; asm volatile("" : "+v"(t_)); F.tid = t_; F.lane = t_ & 63; F.wave = __builtin_amdgcn_readfirstlane(t_ >> 6); }
        int l, kind; decode_phase(p, l, kind);
        const int j = l >> 1; const bool dn = (l & 1) == 0;
        unsigned char* ws = ka->ws;
        switch (kind) {
        case K_P0: p0_prologue(F, ka); break;
        case K_PROJ: {
            const int N = dn ? 4352 : 3072;
            pg8::Gemm g{(const bf16_t*)(ws + ((l & 1) ? WS_X1 : WS_X0)), wl_base(ka, l) + WL_IN, M, N, D, D}; pg8::StaticOrder S; S.init(M, N, F.G, (int)blockIdx.x);
            pg8::EpiBf16 E{(bf16_t*)(ws + WS_R1), dn ? PROJW : 3072, (float*)(ws + WS_BA), dn ? 16 : -1};
            pg8::gemm_phase<pg8::EpiBf16, pg8::StaticOrder>(F.lds, F.tid, g, S, E);
        } break;
        case K_DN_PRE: dn_pre_phase(F, ka, j); break;
        case K_DN_SCAN: dn_scan_naive(F, ka, j); break;
        case K_DN_GATE: dn_gate_phase(F, ka, j); break;
        case K_SC_ACT: sc_act_phase(F, ka, j); break;
        case K_WOUT: {
            const bf16_t* R1 = (const bf16_t*)(ws + WS_R1);
            pg8::Gemm g{dn ? R1 + QKV : R1, wl_base(ka, l) + WL_OUT, M, D, D, dn ? PROJW : 3072}; pg8::StaticOrder S; S.init(M, D, F.G, (int)blockIdx.x);
            pg8::EpiResStats E{(bf16_t*)(ws + ((l & 1) ? WS_X1 : WS_X0)), (float*)(ws + WS_ST1)};
            pg8::gemm_phase<pg8::EpiResStats, pg8::StaticOrder>(F.lds, F.tid, g, S, E);
        } break;
        case K_UP: {
            const float* vb = vec_base(ka, l);
            pg8::Gemm g{(const bf16_t*)(ws + ((l & 1) ? WS_X1 : WS_X0)), wl_base(ka, l) + WL_UP, M, DFF2, D, D}; pg8::StaticOrder S; S.init(M, DFF2, F.G, (int)blockIdx.x);
            pg8::EpiLnFold E{(bf16_t*)(ws + WS_R2), DFF2, (const float*)(ws + WS_ST1), vb, vb + DFF2};
            pg8::gemm_phase<pg8::EpiLnFold, pg8::StaticOrder>(F.lds, F.tid, g, S, E);
        } break;
        case K_ACT: {
            ffn_act_phase(F, ka, l);
            pg8::Gemm g{(const bf16_t*)(ws + WS_PB) + (size_t)l * M * DPLE, wl_base(ka, l) + WL_P, M, D, DPLE, DPLE}; pg8::StaticOrder S; S.init(M, D, F.G, (int)blockIdx.x);
            pg8::EpiBf16 E{(bf16_t*)(ws + WS_R1) + (size_t)M * DFF, D, nullptr, -1};
            pg8::gemm_phase<pg8::EpiBf16, pg8::StaticOrder>(F.lds, F.tid, g, S, E);
        } break;
        case K_DOWN: {
            pg8::Gemm g{(const bf16_t*)(ws + WS_R1), wl_base(ka, l) + WL_DOWN, M, D, DFF, DFF}; pg8::StaticOrder S; S.init(M, D, F.G, (int)blockIdx.x);
            pg8::EpiLnResStats E{(bf16_t*)(ws + ((l & 1) ? WS_X1 : WS_X0)), (const float*)(ws + WS_ST1), (float*)(ws + WS_ST2), ka->in[20] + l * D, ka->in[21] + l * D};
            pg8::gemm_phase<pg8::EpiLnResStats, pg8::StaticOrder>(F.lds, F.tid, g, S, E);
        } break;
        case K_GATE: {
            const float* vb = vec_base(ka, l);
            const bf16_t* Xc = (const bf16_t*)(ws + ((l & 1) ? WS_X1 : WS_X0));
            pg8::Gemm g{Xc, wl_base(ka, l) + WL_G, M, D, D, D}; pg8::StaticOrder S; S.init(M, D, F.G, (int)blockIdx.x);
            pg8::EpiGate E{Xc, (const bf16_t*)(ws + WS_R1) + (size_t)M * DFF, (bf16_t*)(ws + ((l & 1) ? WS_X0 : WS_X1)), l == DEPTH - 1 ? ka->out + O_Y : nullptr, (const float*)(ws + WS_ST2),
                           vb + 2 * DFF2, vb + 2 * DFF2 + D, ka->in[22] + l * D, ka->in[23] + l * D};
            pg8::gemm_phase<pg8::EpiGate, pg8::StaticOrder>(F.lds, F.tid, g, S, E);
        } break;
        default: break;
        }
        if (p + 1 < ph_hi) xcd_barrier(bar);
    }
}

extern "C" void kernel_launch(void* const* d_in, const int* in_sizes, int n_in, void* d_out, int out_size, void* d_ws, size_t ws_size, hipStream_t stream) {
    static int grid = 0;
    if (grid == 0) {
        if (n_in != 26 || out_size != (int)O_END || ws_size < WS_END) { fprintf(stderr, "kernel_launch: unexpected shapes (n_in %d, out %d, ws %zu; need ws >= %zu)\n", n_in, out_size, ws_size, (size_t)WS_END); grid = -1; return; }
        int dev = 0, cus = 0;
        if (hipGetDevice(&dev) != hipSuccess || hipDeviceGetAttribute(&cus, hipDeviceAttributeMultiprocessorCount, dev) != hipSuccess) { grid = -1; return; }
        if (hipFuncSetAttribute((const void*)mk_fwd, hipFuncAttributeMaxDynamicSharedMemorySize, LDS_BYTES) != hipSuccess) { fprintf(stderr, "kernel_launch: hipFuncSetAttribute failed\n"); grid = -1; return; }
        int per_cu = 0; (void)hipOccupancyMaxActiveBlocksPerMultiprocessor(&per_cu, (const void*)mk_fwd, NTHR, LDS_BYTES); (void)hipGetLastError();
        grid = cus;
    }
    if (grid < 0) return;
    (void)hipMemsetAsync((char*)d_ws + WS_CTL, 0, CTL_ZERO_BYTES, stream);
    Args a{};
    for (int i = 0; i < 26; ++i) a.in[i] = (const float*)d_in[i];
    a.out = (float*)d_out; a.ws = (unsigned char*)d_ws;
#if MK_PER_PHASE_LAUNCH
    for (int p = 0; p < N_PHASES; ++p) { a.ph_lo = p; a.ph_hi = p + 1; hipLaunchKernelGGL(mk_fwd, dim3(grid), dim3(NTHR), LDS_BYTES, stream, a); }
#else
    a.ph_lo = 0; a.ph_hi = N_PHASES; hipLaunchKernelGGL(mk_fwd, dim3(grid), dim3(NTHR), LDS_BYTES, stream, a);
#endif
}
```

```cpp
#include <hip/hip_runtime.h>
#include <cstdio>
#include <cstdint>

#ifndef MK_PER_PHASE_LAUNCH
#define MK_PER_PHASE_LAUNCH 0
#endif

#define LAS __attribute__((address_space(3)))
#define GAS __attribute__((address_space(1)))
typedef unsigned short bf16_t;
typedef short bf16x8 __attribute__((ext_vector_type(8)));
typedef float f32x4 __attribute__((ext_vector_type(4)));
typedef float f32x2 __attribute__((ext_vector_type(2)));
typedef unsigned u32x4 __attribute__((ext_vector_type(4)));
typedef unsigned u32x2 __attribute__((ext_vector_type(2)));

constexpr int D = 1024, M_P = 16384, M_S = 1024, M = M_P + M_S, SEQ = 2048, DSEQ = 8, NB_P = 8, NB_S = 128;
constexpr int NH = 8, HD = 128, QKV = 3072, AIN = 4112, PROJW = 4096, DFF = 2816, DFF2 = 5632, DPLE = 256, DEPTH = 4;
constexpr float ALPHA = 1.6817928305074290f;
constexpr float LN_EPS = 1e-5f, RMS_EPS = 1e-6f, L2_EPS = 1e-6f;
constexpr float QSCALE = 0.08838834764831845f;

constexpr size_t O_Y = 0, O_PDNC = 17825792, O_PDNS = O_PDNC + 147456, O_PSC = O_PDNS + 2097152, O_PFFN = O_PSC + 32768,
                 O_SDNC = O_PFFN + 360448, O_SDNS = O_SDNC + 2359296, O_SSC = O_SDNS + 33554432, O_SFFN = O_SSC + 524288, O_END = O_SFFN + 5767168;

constexpr size_t WL_IN = 0, WL_OUT = WL_IN + (size_t)4352 * 1024, WL_UP = WL_OUT + (size_t)1024 * 1024, WL_DOWN = WL_UP + (size_t)DFF2 * 1024,
                 WL_G = WL_DOWN + (size_t)1024 * DFF, WL_P = WL_G + (size_t)1024 * 1024, WL_SIZE = WL_P + (size_t)1024 * 256;
constexpr size_t MiB = 1u << 20;
constexpr size_t WS_CTL = 0, CTL_ZERO_BYTES = 1 * MiB;
constexpr size_t WS_VEC = 1 * MiB;
constexpr size_t VEC_L = 2 * DFF2 + 2 * 1024;
constexpr size_t WS_BA = 2 * MiB;
constexpr size_t WS_GATES = WS_BA + (size_t)M * 16 * 4 + 65536;
constexpr size_t WS_ST1 = 5 * MiB, WS_ST2 = 8 * MiB;
constexpr size_t WS_W23 = 11 * MiB;
constexpr size_t WS_X0 = WS_W23 + 2 * WL_SIZE * 2;
constexpr size_t WS_X1 = WS_X0 + (size_t)M * D * 2;
constexpr size_t WS_PB = WS_X1 + (size_t)M * D * 2;
constexpr size_t WS_R1 = WS_PB + (size_t)4 * M * DPLE * 2;
constexpr size_t WS_R2 = WS_R1 + (size_t)M * PROJW * 2;
constexpr size_t WS_END = WS_R2 + (size_t)M * DFF2 * 2;
static_assert(WS_END <= (size_t)520 * MiB, "workspace budget");
constexpr size_t R2_Q = 0, R2_K = (size_t)M * D * 2, R2_V = 2 * R2_K, R2_O = 3 * R2_K;

__device__ __forceinline__ float bf2f(unsigned b) { return __uint_as_float(b << 16); }
__device__ __forceinline__ unsigned f2bf(float f) { unsigned u = __float_as_uint(f); return (u + 0x7fffu + ((u >> 16) & 1u)) >> 16; }
__device__ __forceinline__ unsigned pk2(float lo, float hi) { return f2bf(lo) | (f2bf(hi) << 16); }
__device__ __forceinline__ float sigmoidf_(float x) { return 1.0f / (1.0f + __expf(-x)); }
__device__ __forceinline__ float siluf_(float x) { return x / (1.0f + __expf(-x)); }
__device__ __forceinline__ void unpack8(const u32x4 w, float (&f)[8]) {
    f[0] = __uint_as_float(w.x << 16); f[1] = __uint_as_float(w.x & 0xffff0000u); f[2] = __uint_as_float(w.y << 16); f[3] = __uint_as_float(w.y & 0xffff0000u);
    f[4] = __uint_as_float(w.z << 16); f[5] = __uint_as_float(w.z & 0xffff0000u); f[6] = __uint_as_float(w.w << 16); f[7] = __uint_as_float(w.w & 0xffff0000u);
}
__device__ __forceinline__ u32x4 pack8(const float (&f)[8]) { u32x4 w; w.x = pk2(f[0], f[1]); w.y = pk2(f[2], f[3]); w.z = pk2(f[4], f[5]); w.w = pk2(f[6], f[7]); return w; }
__device__ __forceinline__ float wave_sum(float v) {
#pragma unroll
    for (int o = 1; o < 64; o <<= 1) v += __shfl_xor(v, o);
    return v;
}
__device__ __forceinline__ void row_info(int r, int& b, int& t, int& L, bool& smp) {
    if (r < M_P) { b = r >> 11; t = r & 2047; L = SEQ; smp = false; } else { const int q = r - M_P; b = q >> 3; t = q & 7; L = DSEQ; smp = true; }
}

namespace pg8 {
constexpr int BM = 256, BK = 64, HALF = 128, HTB = HALF * BK * 2, STAGE_BYTES = 8 * HTB, NXCD = 8, WGM = 8;
__host__ __device__ __forceinline__ int lds_byte(int r, int c) { const int st = (r >> 4) * 2 + (c >> 5), rr = r & 15, cc = c & 31, ob = rr * 64 + cc * 2; return st * 1024 + (ob ^ (((ob >> 9) & 1) << 5)); }
__host__ __device__ __forceinline__ void stage_rc(int b, int& R, int& C) { const int st = b / 1024, sb = b % 1024, swz = sb ^ (((sb >> 9) & 1) << 5); R = (st >> 1) * 16 + swz / 64; C = (st & 1) * 32 + (swz % 64) / 2; }
__host__ __device__ __forceinline__ int perm32(int rho) { const int n = rho >> 4, i = rho & 15; return 8 * (i >> 2) + 4 * n + (i & 3); }

struct Unit { int pm, pn; };
struct Gemm { const bf16_t* A; const bf16_t* Bt; int M, N, K, lda; };

struct StaticOrder {
    int nM, nN, nwg, G, c;
    __host__ __device__ void init(int M_, int N_, int G_, int c_) { nM = M_ / BM; nN = N_ / BM; nwg = nM * nN; G = G_; c = c_; }
    __host__ __device__ bool next(int i, Unit& u) const {
        const long L = (long)i * G + c; if (L >= nwg) return false;
        int wgid = (int)L; { const int q = nwg / NXCD, r = nwg % NXCD, xcd = wgid % NXCD, off = wgid / NXCD; wgid = (xcd < r ? xcd * (q + 1) : r * (q + 1) + (xcd - r) * q) + off; }
        const int nig = WGM * nN, gid = wgid / nig, fm = gid * WGM, gsz = (nM - fm) < WGM ? (nM - fm) : WGM;
        u.pm = fm + ((wgid % nig) % gsz); u.pn = (wgid % nig) / gsz; return true;
    }
    __device__ __forceinline__ void a_ready(const Unit&) const {}
    __device__ __forceinline__ void done(const Unit&) const {}
};

typedef f32x4 Acc[2][2][4][2];

__device__ __forceinline__ void row_stats(const float* st  , int row, int fq, float& mu, float& rstd) {
    const f32x4* p = (const f32x4*)(st + (size_t)row * 32 + 8 * fq);
    const f32x4 a = p[0], b = p[1];
    float s = (a.x + a.z) + (b.x + b.z), q = (a.y + a.w) + (b.y + b.w);
    s += __shfl_xor(s, 16); s += __shfl_xor(s, 32); q += __shfl_xor(q, 16); q += __shfl_xor(q, 32);
    mu = s * (1.0f / 1024.0f); const float var = fmaxf(q * (1.0f / 1024.0f) - mu * mu, 0.f); rstd = rsqrtf(var + LN_EPS);
}

struct EpiBf16 {
    static constexpr bool PERM = true;
    bf16_t* O; int ldc; float* ba; int ba_pn;
    __device__ __forceinline__ void operator()(const Acc& acc, const Unit& u, int wr, int wc, int fr, int fq) const {
        const int row0 = u.pm * BM + wr * 64 + fr;
        if (u.pn == ba_pn) {
            if (wc == 0 && fq < 2) {
#pragma unroll
                for (int ai = 0; ai < 2; ++ai)
#pragma unroll
                    for (int m = 0; m < 4; ++m) { float* p = ba + (size_t)(row0 + ai * HALF + m * 16) * 16 + 8 * fq; *(f32x4*)p = acc[ai][0][m][0]; *(f32x4*)(p + 4) = acc[ai][0][m][1]; }
            }
            return;
        }
        const int col0 = u.pn * BM + wc * 32 + 8 * fq;
#pragma unroll
        for (int ai = 0; ai < 2; ++ai)
#pragma unroll
            for (int m = 0; m < 4; ++m) { bf16_t* rowp = O + (size_t)(row0 + ai * HALF + m * 16) * ldc + col0;
#pragma unroll
                for (int bj = 0; bj < 2; ++bj) { const f32x4 v0 = acc[ai][bj][m][0], v1 = acc[ai][bj][m][1];
                    u32x4 w; w.x = pk2(v0[0], v0[1]); w.y = pk2(v0[2], v0[3]); w.z = pk2(v1[0], v1[1]); w.w = pk2(v1[2], v1[3]);
                    *(u32x4*)(rowp + bj * HALF) = w; } }
    }
};
struct EpiResStats {
    static constexpr bool PERM = true;
    bf16_t* X; float* st;
    __device__ __forceinline__ void operator()(const Acc& acc, const Unit& u, int wr, int wc, int fr, int fq) const {
        const int row0 = u.pm * BM + wr * 64 + fr, col0 = u.pn * BM + wc * 32 + 8 * fq;
#pragma unroll
        for (int ai = 0; ai < 2; ++ai)
#pragma unroll
            for (int m = 0; m < 4; ++m) { const int row = row0 + ai * HALF + m * 16; bf16_t* rowp = X + (size_t)row * D + col0; float s = 0.f, q = 0.f;
#pragma unroll
                for (int bj = 0; bj < 2; ++bj) { float x[8]; unpack8(*(const u32x4*)(rowp + bj * HALF), x); const f32x4 v0 = acc[ai][bj][m][0], v1 = acc[ai][bj][m][1];
#pragma unroll
                    for (int e = 0; e < 4; ++e) { x[e] = ALPHA * x[e] + v0[e]; x[4 + e] = ALPHA * x[4 + e] + v1[e]; }
#pragma unroll
                    for (int e = 0; e < 8; ++e) { s += x[e]; q += x[e] * x[e]; }
                    *(u32x4*)(rowp + bj * HALF) = pack8(x); }
                s += __shfl_xor(s, 16); s += __shfl_xor(s, 32); q += __shfl_xor(q, 16); q += __shfl_xor(q, 32);
                if (fq == 0) *(f32x2*)(st + ((size_t)row * 16 + u.pn * 4 + wc) * 2) = (f32x2){s, q}; }
    }
};
struct EpiLnResStats {
    static constexpr bool PERM = true;
    bf16_t* X; const float* st_in; float* st_out; const float* g; const float* b;
    __device__ __forceinline__ void operator()(const Acc& acc, const Unit& u, int wr, int wc, int fr, int fq) const {
        const int row0 = u.pm * BM + wr * 64 + fr, col0 = u.pn * BM + wc * 32 + 8 * fq;
        f32x4 gv[2][2], bv[2][2];
#pragma unroll
        for (int bj = 0; bj < 2; ++bj)
#pragma unroll
            for (int n = 0; n < 2; ++n) { gv[bj][n] = *(const f32x4*)(g + col0 + bj * HALF + 4 * n); bv[bj][n] = *(const f32x4*)(b + col0 + bj * HALF + 4 * n); }
#pragma unroll
        for (int ai = 0; ai < 2; ++ai)
#pragma unroll
            for (int m = 0; m < 4; ++m) { const int row = row0 + ai * HALF + m * 16; bf16_t* rowp = X + (size_t)row * D + col0; float s = 0.f, q = 0.f;
                float mu, rs; row_stats(st_in, row, fq, mu, rs);
#pragma unroll
                for (int bj = 0; bj < 2; ++bj) { float x[8]; unpack8(*(const u32x4*)(rowp + bj * HALF), x); const f32x4 v0 = acc[ai][bj][m][0], v1 = acc[ai][bj][m][1];
#pragma unroll
                    for (int e = 0; e < 4; ++e) { x[e] = ALPHA * ((x[e] - mu) * rs * gv[bj][0][e] + bv[bj][0][e]) + v0[e]; x[4 + e] = ALPHA * ((x[4 + e] - mu) * rs * gv[bj][1][e] + bv[bj][1][e]) + v1[e]; }
#pragma unroll
                    for (int e = 0; e < 8; ++e) { s += x[e]; q += x[e] * x[e]; }
                    *(u32x4*)(rowp + bj * HALF) = pack8(x); }
                s += __shfl_xor(s, 16); s += __shfl_xor(s, 32); q += __shfl_xor(q, 16); q += __shfl_xor(q, 32);
                if (fq == 0) *(f32x2*)(st_out + ((size_t)row * 16 + u.pn * 4 + wc) * 2) = (f32x2){s, q}; }
    }
};
struct EpiLnFold {
    static constexpr bool PERM = true;
    bf16_t* O; int ldc; const float* st; const float* c1; const float* c2;
    __device__ __forceinline__ void operator()(const Acc& acc, const Unit& u, int wr, int wc, int fr, int fq) const {
        const int row0 = u.pm * BM + wr * 64 + fr, col0 = u.pn * BM + wc * 32 + 8 * fq;
        f32x4 c1v[2][2], c2v[2][2];
#pragma unroll
        for (int bj = 0; bj < 2; ++bj)
#pragma unroll
            for (int n = 0; n < 2; ++n) { c1v[bj][n] = *(const f32x4*)(c1 + col0 + bj * HALF + 4 * n); c2v[bj][n] = *(const f32x4*)(c2 + col0 + bj * HALF + 4 * n); }
#pragma unroll
        for (int ai = 0; ai < 2; ++ai)
#pragma unroll
            for (int m = 0; m < 4; ++m) { const int row = row0 + ai * HALF + m * 16; bf16_t* rowp = O + (size_t)row * ldc + col0;
                float mu, rs; row_stats(st, row, fq, mu, rs);
#pragma unroll
                for (int bj = 0; bj < 2; ++bj) { const f32x4 v0 = (acc[ai][bj][m][0] - mu * c1v[bj][0]) * rs + c2v[bj][0], v1 = (acc[ai][bj][m][1] - mu * c1v[bj][1]) * rs + c2v[bj][1];
                    u32x4 w; w.x = pk2(v0[0], v0[1]); w.y = pk2(v0[2], v0[3]); w.z = pk2(v1[0], v1[1]); w.w = pk2(v1[2], v1[3]);
                    *(u32x4*)(rowp + bj * HALF) = w; } }
    }
};
struct EpiGate {
    static constexpr bool PERM = true;
    const bf16_t* H; const bf16_t* PP; bf16_t* XO; float* Y; const float* st; const float* c1; const float* c2; const float* g; const float* b;
    __device__ __forceinline__ void operator()(const Acc& acc, const Unit& u, int wr, int wc, int fr, int fq) const {
        const int row0 = u.pm * BM + wr * 64 + fr, col0 = u.pn * BM + wc * 32 + 8 * fq;
#pragma unroll
        for (int ai = 0; ai < 2; ++ai)
#pragma unroll
            for (int m = 0; m < 4; ++m) { const int row = row0 + ai * HALF + m * 16; const size_t off = (size_t)row * D + col0;
                float mu, rs; row_stats(st, row, fq, mu, rs);
#pragma unroll
                for (int bj = 0; bj < 2; ++bj) { float h[8], pp[8], o[8]; unpack8(*(const u32x4*)(H + off + bj * HALF), h); unpack8(*(const u32x4*)(PP + off + bj * HALF), pp);
#pragma unroll
                    for (int n = 0; n < 2; ++n) { const int cc = col0 + bj * HALF + 4 * n; const f32x4 c1v = *(const f32x4*)(c1 + cc), c2v = *(const f32x4*)(c2 + cc), gv = *(const f32x4*)(g + cc), bv = *(const f32x4*)(b + cc);
#pragma unroll
                        for (int e = 0; e < 4; ++e) { const float gate = (acc[ai][bj][m][n][e] - mu * c1v[e]) * rs + c2v[e]; const float x2 = (h[4 * n + e] - mu) * rs * gv[e] + bv[e];
                            o[4 * n + e] = x2 + pp[4 * n + e] * sigmoidf_(gate); } }
                    *(u32x4*)(XO + off + bj * HALF) = pack8(o);
                    if (Y) { *(f32x4*)(Y + off + bj * HALF) = (f32x4){o[0], o[1], o[2], o[3]}; *(f32x4*)(Y + off + bj * HALF + 4) = (f32x4){o[4], o[5], o[6], o[7]}; } } }
    }
};

template <class Epi, class Sched, bool ALIGN_EPI = true>
__device__ __forceinline__ void gemm_phase(LAS unsigned char* lds, const int tid, const Gemm g, const Sched& S, const Epi& E) {
    const int wid = __builtin_amdgcn_readfirstlane(tid >> 6), lane = tid & 63, wr = wid >> 2, wc = wid & 3, fr = lane & 15, fq = lane >> 4;
    const int K = g.K, nt = K / BK, lda = g.lda;
    unsigned voffA[2], voffB[2];
#pragma unroll
    for (int i = 0; i < 2; ++i) { int R, C; stage_rc(tid * 16 + i * 8192, R, C); const int Rb = Epi::PERM ? ((R & ~31) + perm32(R & 31)) : R;
        voffA[i] = (unsigned)(R * lda + C) * 2u; voffB[i] = (unsigned)(Rb * K + C) * 2u; }
    const size_t kstep = (size_t)(BK * 2);
    const size_t hstepA = (size_t)HALF * lda * 2, hstepB = (size_t)HALF * K * 2;
    const size_t tstepA = 2 * hstepA, tstepB = 2 * hstepB;
    const unsigned ldsw = (unsigned)wid * 1024u;
    const int aoff = lds_byte(wr * 64 + fr, fq * 8), boff = lds_byte(wc * 32 + fr, fq * 8);
#define PG8_SA(b, h) (((b) * 2 + (h)) * HTB)
#define PG8_SB(b, h) ((4 + (b) * 2 + (h)) * HTB)
#define PG8_STAGE(bufoff, gbase, voff) do { _Pragma("unroll") for (int _i = 0; _i < 2; ++_i) \
        __builtin_amdgcn_global_load_lds((const unsigned*)((const char*)(gbase) + (voff)[_i]), (LAS unsigned*)(lds + (bufoff) + ldsw + _i * 8192), 16, 0, 0); } while (0)
#define PG8_LDA(dst, b, h) do { _Pragma("unroll") for (int m = 0; m < 4; ++m) _Pragma("unroll") for (int k = 0; k < 2; ++k) dst[m][k] = *(const LAS bf16x8*)(lds + PG8_SA(b, h) + aoff + m * 2048 + k * 1024); } while (0)
#define PG8_LDB(dst, b, h) do { _Pragma("unroll") for (int n = 0; n < 2; ++n) _Pragma("unroll") for (int k = 0; k < 2; ++k) dst[n][k] = *(const LAS bf16x8*)(lds + PG8_SB(b, h) + boff + n * 2048 + k * 1024); } while (0)
#define PG8_MMA(ai, bj, At, Bt) do { __builtin_amdgcn_s_setprio(1); _Pragma("unroll") for (int m = 0; m < 4; ++m) _Pragma("unroll") for (int n = 0; n < 2; ++n) _Pragma("unroll") for (int k = 0; k < 2; ++k) \
        acc[ai][bj][m][n] = __builtin_amdgcn_mfma_f32_16x16x32_bf16(Bt[n][k], At[m][k], acc[ai][bj][m][n], 0, 0, 0); __builtin_amdgcn_s_setprio(0); } while (0)
#define PG8_WAIT_V(n) asm volatile("s_waitcnt vmcnt(" #n ")" ::: "memory")
#define PG8_WAIT_L(n) asm volatile("s_waitcnt lgkmcnt(" #n ")" ::: "memory")
#define PG8_BAR __builtin_amdgcn_s_barrier()
#define PG8_SCHED __builtin_amdgcn_sched_barrier(0)
    Unit cur, nxt; int ui = 0;
    if (!S.next(0, cur)) return;
    f32x4 acc[2][2][4][2];
#pragma unroll
    for (int a = 0; a < 2; ++a)
#pragma unroll
        for (int b = 0; b < 2; ++b)
#pragma unroll
            for (int m = 0; m < 4; ++m)
#pragma unroll
                for (int n = 0; n < 2; ++n) acc[a][b][m][n] = (f32x4){0.f, 0.f, 0.f, 0.f};
    bf16x8 At[4][2], B0[2][2], B1[2][2];
    const char* cA = (const char*)g.A + (size_t)cur.pm * tstepA; const char* cB = (const char*)g.Bt + (size_t)cur.pn * tstepB;
    S.a_ready(cur);
    PG8_STAGE(PG8_SB(0, 0), cB, voffB); PG8_STAGE(PG8_SB(0, 1), cB + hstepB, voffB); PG8_STAGE(PG8_SA(0, 0), cA, voffA); PG8_STAGE(PG8_SA(0, 1), cA + hstepA, voffA);
    if (wr == 1) PG8_BAR;
    PG8_WAIT_V(2); PG8_BAR;
    PG8_STAGE(PG8_SB(1, 0), cB + kstep, voffB); PG8_STAGE(PG8_SA(1, 0), cA + kstep, voffA); PG8_STAGE(PG8_SB(1, 1), cB + hstepB + kstep, voffB);
    PG8_WAIT_V(6); PG8_BAR;
    for (;;) {
        const bool has_next = S.next(ui + 1, nxt);
        const char* nA = has_next ? (const char*)g.A + (size_t)nxt.pm * tstepA : cA; const char* nB = has_next ? (const char*)g.Bt + (size_t)nxt.pn * tstepB : cB;
        for (int t = 0; t < nt; t += 2) {
            const bool last = (t == nt - 2);
            const char* a1 = cA + (size_t)(t + 1) * kstep;
            const char* a2 = last ? nA : cA + (size_t)(t + 2) * kstep; const char* b2 = last ? nB : cB + (size_t)(t + 2) * kstep;
            const char* a3 = a2 + kstep; const char* b3 = b2 + kstep;
            if (last && has_next) S.a_ready(nxt);
            PG8_LDB(B0, 0, 0); PG8_LDB(B1, 0, 1); PG8_SCHED; PG8_LDA(At, 0, 0); PG8_STAGE(PG8_SA(1, 1), a1 + hstepA, voffA);
            PG8_WAIT_V(8); PG8_WAIT_L(0); PG8_BAR; PG8_MMA(0, 0, At, B0); PG8_MMA(0, 1, At, B1); PG8_BAR; PG8_SCHED;
            PG8_LDA(At, 0, 1); PG8_STAGE(PG8_SB(0, 0), b2, voffB); PG8_STAGE(PG8_SB(0, 1), b2 + hstepB, voffB); PG8_STAGE(PG8_SA(0, 0), a2, voffA);
            PG8_WAIT_V(8); PG8_WAIT_L(0); PG8_BAR; PG8_MMA(1, 0, At, B0); PG8_MMA(1, 1, At, B1); PG8_BAR; PG8_SCHED;
            PG8_LDB(B0, 1, 0); PG8_LDB(B1, 1, 1); PG8_SCHED; PG8_LDA(At, 1, 0); PG8_STAGE(PG8_SA(0, 1), a2 + hstepA, voffA);
            PG8_WAIT_V(8); PG8_WAIT_L(0); PG8_BAR; PG8_MMA(0, 0, At, B0); PG8_MMA(0, 1, At, B1); PG8_BAR; PG8_SCHED;
            PG8_LDA(At, 1, 1); PG8_STAGE(PG8_SB(1, 0), b3, voffB); PG8_STAGE(PG8_SB(1, 1), b3 + hstepB, voffB); PG8_STAGE(PG8_SA(1, 0), a3, voffA);
            PG8_WAIT_V(8); PG8_WAIT_L(0); PG8_BAR; PG8_MMA(1, 0, At, B0); PG8_MMA(1, 1, At, B1); PG8_BAR; PG8_SCHED;
        }
        if constexpr (ALIGN_EPI) { if (wr == 0) PG8_BAR; }
        E(acc, cur, wr, wc, fr, fq); S.done(cur);
        if (!has_next) break;
#pragma unroll
        for (int a = 0; a < 2; ++a)
#pragma unroll
            for (int b = 0; b < 2; ++b)
#pragma unroll
                for (int m = 0; m < 4; ++m)
#pragma unroll
                    for (int n = 0; n < 2; ++n) acc[a][b][m][n] = (f32x4){0.f, 0.f, 0.f, 0.f};
        cur = nxt; cA = nA; cB = nB; ++ui;
        if constexpr (ALIGN_EPI) { if (wr == 1) PG8_BAR; }
    }
    PG8_WAIT_V(0);
    if constexpr (!ALIGN_EPI) { if (wr == 0) PG8_BAR; }
    PG8_BAR;
#undef PG8_SA
#undef PG8_SB
#undef PG8_STAGE
#undef PG8_LDA
#undef PG8_LDB
#undef PG8_MMA
#undef PG8_WAIT_V
#undef PG8_WAIT_L
#undef PG8_BAR
#undef PG8_SCHED
}
}

constexpr int NWAVES = 8, NTHR = NWAVES * 64;
constexpr int RING_BYTES = 131072, LDSCTL_OFF = RING_BYTES, MISC_OFF = LDSCTL_OFF + 320, LDS_BYTES = 147456;
typedef GAS unsigned gu32;
#define RLX_AGENT __ATOMIC_RELAXED, __HIP_MEMORY_SCOPE_AGENT

#define XB_TMO      128
#define XB_XCNT(j)  (256  + 64 * (j))
#define XB_XSUB(j)  (1280 + 64 * (j))
#define XB_XGEN(j)  (2304 + 64 * (j))
#define XB_TOP      3328
#define XB_TOPGEN   3392
#define XCD_BAR_WORDS 3456
#define XB_SPIN_CAP (1u << 18)
constexpr int CW_BAR = 4096;
__device__ __forceinline__ unsigned xb_ld(unsigned* p)              { return __hip_atomic_load(p, __ATOMIC_RELAXED, __HIP_MEMORY_SCOPE_AGENT); }
__device__ __forceinline__ unsigned xb_add(unsigned* p, unsigned v) { return __hip_atomic_fetch_add(p, v, __ATOMIC_RELAXED, __HIP_MEMORY_SCOPE_AGENT); }
__device__ __forceinline__ unsigned xb_xcc_id() { return (unsigned)__builtin_amdgcn_s_getreg((3 << 11) | 20) & 0xFu; }
#define XB_SPIN(cond, bar) do { unsigned _sp = 0; while (cond) { __builtin_amdgcn_s_sleep(1); \
    if ((++_sp & 255u) == 0u) { if (xb_ld(&(bar)[XB_TMO])) break; if (_sp > XB_SPIN_CAP) { atomicAdd(&(bar)[XB_TMO], 1u); break; } } } } while (0)
struct XcdBarrier { unsigned* bar; unsigned x; volatile LAS unsigned* st; };
__device__ __forceinline__ XcdBarrier xcd_barrier_post(unsigned* bar, volatile LAS unsigned* st) {
    XcdBarrier b; b.bar = bar; b.x = xb_xcc_id(); b.st = st;
    if (threadIdx.x == 0) (void)xb_add(&bar[XB_XCNT(b.x)], 1u);
    return b;
}
__device__ __forceinline__ void xcd_barrier_complete(unsigned* bar, unsigned x, unsigned& nloc, unsigned& nx) {
    const unsigned G = gridDim.x * gridDim.y * gridDim.z;
    unsigned sum, cnt, mine, sp = 0u;
    for (;;) {
        sum = 0u; cnt = 0u; mine = 0u;
#pragma unroll
        for (unsigned j = 0; j < 16; ++j) { const unsigned c = xb_ld(&bar[XB_XCNT(j)]); sum += c; cnt += (c > 0u) ? 1u : 0u; mine = (j == x) ? c : mine; }
        if (sum == G) break;
        __builtin_amdgcn_s_sleep(1);
        if ((++sp & 255u) == 0u) { if (xb_ld(&bar[XB_TMO])) break; if (sp > XB_SPIN_CAP) { atomicAdd(&bar[XB_TMO], 1u); break; } }
    }
    nloc = mine > 0u ? mine : 1u; nx = cnt > 0u ? cnt : 1u;
}
__device__ __forceinline__ void xcd_barrier(const XcdBarrier& b) {
    asm volatile("s_waitcnt vmcnt(0)" ::: "memory");
    __syncthreads();
    if (threadIdx.x == 0) {
        unsigned* bar = b.bar;
        __builtin_amdgcn_s_waitcnt(0);
        unsigned nloc = b.st[0], nx = b.st[1];
        if (nloc == 0u) { xcd_barrier_complete(bar, b.x, nloc, nx); b.st[0] = nloc; b.st[1] = nx; }
        const unsigned old = xb_add(&bar[XB_XSUB(b.x)], 1u);
        const unsigned gen = old / nloc;
        if (old + 1u == (gen + 1u) * nloc) {
            __builtin_amdgcn_fence(__ATOMIC_RELEASE, "agent");
            asm volatile("s_waitcnt vmcnt(0)" ::: "memory");
            const unsigned og = xb_add(&bar[XB_TOP], 1u);
            const unsigned tg = og / nx;
            if (og + 1u == (tg + 1u) * nx) xb_add(&bar[XB_TOPGEN], 1u);
            else XB_SPIN(xb_ld(&bar[XB_TOPGEN]) == tg, bar);
            __builtin_amdgcn_fence(__ATOMIC_ACQUIRE, "agent");
            xb_add(&bar[XB_XGEN(b.x)], 1u);
            asm volatile("s_waitcnt vmcnt(0)" ::: "memory");
        } else {
            XB_SPIN(xb_ld(&bar[XB_XGEN(b.x)]) == gen, bar);
            __builtin_amdgcn_fence(__ATOMIC_ACQUIRE, "agent");
            asm volatile("s_waitcnt vmcnt(0)" ::: "memory");
        }
    }
    __syncthreads();
}

struct Args {
    const float* in[26]; float* out; unsigned char* ws; int ph_lo, ph_hi;
};
struct Frame {
    LAS unsigned char* lds; int tid, lane, wave, vcu, G;
};
typedef const __attribute__((address_space(4))) Args* KArgs;
__device__ __forceinline__ bf16_t* wl_base(KArgs a, int l) {
    return l < 2 ? (bf16_t*)(a->out + O_SDNS + (size_t)NB_S * NH * HD * HD) + (size_t)l * WL_SIZE : (bf16_t*)(a->ws + WS_W23) + (size_t)(l - 2) * WL_SIZE;
}
__device__ __forceinline__ float* vec_base(KArgs a, int l) { return (float*)(a->ws + WS_VEC) + (size_t)l * VEC_L; }

__device__ __forceinline__ void p0_transpose_item(const float* W, int K, int N, int ldn, const float* gk, bf16_t* WT, LAS float* scr, int item, int nblk, int lane) {
    const int kb = item / nblk, nb = item % nblk, k0 = 64 * kb, n0 = 32 * nb;
    const int n = n0 + (lane & 31);
#pragma unroll 8
    for (int i = 0; i < 32; ++i) { const int kk = 2 * i + (lane >> 5); float v = (n < N) ? W[(size_t)(k0 + kk) * ldn + n] : 0.f; if (gk) v *= gk[k0 + kk]; scr[kk * 33 + (lane & 31)] = v; }
    asm volatile("s_waitcnt lgkmcnt(0)" ::: "memory");
    const int c = lane & 7;
#pragma unroll
    for (int j = 0; j < 4; ++j) { const int nn = (lane >> 3) + 8 * j; const LAS float* s = scr + (8 * c) * 33 + nn;
        u32x4 o; o.x = pk2(s[0 * 33], s[1 * 33]); o.y = pk2(s[2 * 33], s[3 * 33]); o.z = pk2(s[4 * 33], s[5 * 33]); o.w = pk2(s[6 * 33], s[7 * 33]);
        *(u32x4*)(WT + (size_t)(n0 + nn) * K + k0 + 8 * c) = o; }
    asm volatile("s_waitcnt lgkmcnt(0)" ::: "memory");
}
__device__ __forceinline__ void p0_transpose(const Frame& F, const float* W, int K, int N, int Npad, const float* gk, bf16_t* WT) {
    LAS float* scr = (LAS float*)(F.lds + F.wave * 16384);
    const int gw = F.vcu * NWAVES + F.wave, NGW = F.G * NWAVES, nblk = Npad / 32, nitems = (K / 64) * nblk;
    for (int it = gw; it < nitems; it += NGW) p0_transpose_item(W, K, N, N, gk, WT, scr, it, nblk, F.lane);
}
__device__ __forceinline__ void p0_prologue(const Frame& F, KArgs a) {
    for (int l = 0; l < DEPTH; ++l) {
        bf16_t* wb = wl_base(a, l); const int j = l >> 1;
        if ((l & 1) == 0) { p0_transpose(F, a->in[8] + (size_t)j * D * AIN, D, AIN, 4352, nullptr, wb + WL_IN); p0_transpose(F, a->in[13] + (size_t)j * D * D, D, D, D, nullptr, wb + WL_OUT); }
        else { p0_transpose(F, a->in[14] + (size_t)j * D * 3 * D, D, 3 * D, 3 * D, nullptr, wb + WL_IN); p0_transpose(F, a->in[16] + (size_t)j * D * D, D, D, D, nullptr, wb + WL_OUT); }
        p0_transpose(F, a->in[17] + (size_t)l * D * DFF2, D, DFF2, DFF2, a->in[20] + l * D, wb + WL_UP);
        p0_transpose(F, a->in[19] + (size_t)l * DFF * D, DFF, D, D, nullptr, wb + WL_DOWN);
        p0_transpose(F, a->in[25] + (size_t)l * D * D, D, D, D, a->in[22] + l * D, wb + WL_G);
        p0_transpose(F, a->in[24] + (size_t)l * DPLE * D, DPLE, D, D, nullptr, wb + WL_P);
    }
    const int gt = F.vcu * NTHR + F.tid, NGT = F.G * NTHR;
    for (int it = gt; it < DEPTH * (DFF2 + D); it += NGT) {
        const int l = it / (DFF2 + D), n0 = it % (DFF2 + D); const bool up = n0 < DFF2; const int n = up ? n0 : n0 - DFF2, N = up ? DFF2 : D;
        const float* W = up ? a->in[17] + (size_t)l * D * DFF2 : a->in[25] + (size_t)l * D * D;
        const float* g = (up ? a->in[20] : a->in[22]) + l * D; const float* b = (up ? a->in[21] : a->in[23]) + l * D;
        float s1 = 0.f, s2 = 0.f;
        for (int k = 0; k < D; ++k) { const float w = W[(size_t)k * N + n]; s1 += bf2f(f2bf(g[k] * w)); s2 += b[k] * w; }
        float* vb = vec_base(a, l); if (up) { vb[n] = s1; vb[DFF2 + n] = s2; } else { vb[2 * DFF2 + n] = s1; vb[2 * DFF2 + D + n] = s2; }
    }
    bf16_t* X0 = (bf16_t*)(a->ws + WS_X0); bf16_t* PB = (bf16_t*)(a->ws + WS_PB);
    for (size_t i = gt; i < (size_t)M * D / 8; i += NGT) { const size_t e = i * 8; const float* src = e < (size_t)M_P * D ? a->in[0] + e : a->in[1] + (e - (size_t)M_P * D);
        const f32x4 v0 = *(const f32x4*)src, v1 = *(const f32x4*)(src + 4); u32x4 w; w.x = pk2(v0[0], v0[1]); w.y = pk2(v0[2], v0[3]); w.z = pk2(v1[0], v1[1]); w.w = pk2(v1[2], v1[3]); *(u32x4*)(X0 + e) = w; }
    for (size_t i = gt; i < (size_t)DEPTH * M * DPLE / 8; i += NGT) { const size_t e = i * 8; const size_t l = e / ((size_t)M * DPLE), r = e % ((size_t)M * DPLE);
        const float* src = r < (size_t)M_P * DPLE ? a->in[2] + l * (size_t)M_P * DPLE + r : a->in[3] + l * (size_t)M_S * DPLE + (r - (size_t)M_P * DPLE);
        const f32x4 v0 = *(const f32x4*)src, v1 = *(const f32x4*)(src + 4); u32x4 w; w.x = pk2(v0[0], v0[1]); w.y = pk2(v0[2], v0[3]); w.z = pk2(v1[0], v1[1]); w.w = pk2(v1[2], v1[3]); *(u32x4*)(PB + e) = w; }
}

__device__ __forceinline__ void dn_pre_phase(const Frame& F, KArgs a, int j) {
    const bf16_t* proj = (const bf16_t*)(a->ws + WS_R1); const float* ba = (const float*)(a->ws + WS_BA);
    bf16_t* Q = (bf16_t*)(a->ws + WS_R2 + R2_Q); bf16_t* Kb = (bf16_t*)(a->ws + WS_R2 + R2_K); bf16_t* V = (bf16_t*)(a->ws + WS_R2 + R2_V);
    float* beta = (float*)(a->ws + WS_GATES); float* gg = beta + (size_t)M * 8;
    const float* cw = a->in[9] + (size_t)j * 4 * QKV; const float* sbuf = a->in[4] + (size_t)j * NB_S * 3 * QKV;
    const int gw = F.vcu * NWAVES + F.wave, NGW = F.G * NWAVES, lane = F.lane;
    for (int it = gw; it < M * NH; it += NGW) {
        const int r = it >> 3, h = it & 7; int b, t, L; bool smp; row_info(r, b, t, L, smp);
        float res[3][2];
#pragma unroll
        for (int part = 0; part < 3; ++part) {
            const int col = part * 1024 + h * HD + 2 * lane; float y0 = 0.f, y1 = 0.f;
#pragma unroll
            for (int jj = 0; jj < 4; ++jj) { const int d = 3 - jj; float u0, u1;
                if (t - d >= 0) { const unsigned w = *(const unsigned*)(proj + (size_t)(r - d) * PROJW + col); u0 = bf2f(w & 0xffffu); u1 = bf2f(w >> 16); }
                else if (smp) { const float* p = sbuf + ((size_t)b * 3 + (t + jj)) * QKV + col; u0 = p[0]; u1 = p[1]; }
                else { u0 = 0.f; u1 = 0.f; }
                const f32x2 wv = *(const f32x2*)(cw + (size_t)jj * QKV + col); y0 += wv.x * u0; y1 += wv.y * u1;
                if (jj == 3 && t >= L - 3) { float* o = a->out + (smp ? O_SDNC : O_PDNC) + (((size_t)j * (smp ? NB_S : NB_P) + b) * 3 + (t - (L - 3))) * QKV + col; o[0] = u0; o[1] = u1; } }
            res[part][0] = siluf_(y0); res[part][1] = siluf_(y1);
        }
        const float sq = wave_sum(res[0][0] * res[0][0] + res[0][1] * res[0][1]), sk = wave_sum(res[1][0] * res[1][0] + res[1][1] * res[1][1]);
        const float rq = rsqrtf(sq + L2_EPS) * QSCALE, rk = rsqrtf(sk + L2_EPS);
        const size_t o = (size_t)r * D + h * HD + 2 * lane;
        *(unsigned*)(Q + o) = pk2(res[0][0] * rq, res[0][1] * rq); *(unsigned*)(Kb + o) = pk2(res[1][0] * rk, res[1][1] * rk); *(unsigned*)(V + o) = pk2(res[2][0], res[2][1]);
        if (lane == 0) { const float b1 = ba[(size_t)r * 16 + h], b2 = ba[(size_t)r * 16 + 8 + h] + a->in[11][j * 8 + h];
            const float sp = b2 > 20.f ? b2 : log1pf(expf(b2));
            beta[(size_t)r * 8 + h] = sigmoidf_(b1); gg[(size_t)r * 8 + h] = -expf(a->in[10][j * 8 + h]) * sp; }
    }
}
__device__ __forceinline__ void dn_scan_naive(const Frame& F, KArgs a, int j) {
    const bf16_t* Q = (const bf16_t*)(a->ws + WS_R2 + R2_Q); const bf16_t* Kb = (const bf16_t*)(a->ws + WS_R2 + R2_K); const bf16_t* V = (const bf16_t*)(a->ws + WS_R2 + R2_V);
    float* O = (float*)(a->ws + WS_R2 + R2_O);
    const float* beta = (const float*)(a->ws + WS_GATES); const float* gg = beta + (size_t)M * 8;
    LAS float* sk = (LAS float*)F.lds;
    LAS float* sq = sk + 32 * 128;
    LAS float* sv = sq + 32 * 128;
    LAS float* sg = sv + 32 * 128;
    LAS float* red = sg + 64;
    LAS float* red2 = red + 2 * 512;
    const int tid = F.tid, v = tid & 127, kq = tid >> 7;
    for (int u = F.vcu; u < NB_P * NH + NB_S * NH; u += F.G) {
        const bool smp = u >= NB_P * NH; const int uu = smp ? u - NB_P * NH : u, b = uu >> 3, h = uu & 7, L = smp ? DSEQ : SEQ;
        const int row0 = smp ? M_P + b * DSEQ : b * SEQ;
        float S[32];
        if (smp) { const float* s0 = a->in[5] + (((size_t)j * NB_S + b) * NH + h) * HD * HD;
#pragma unroll
            for (int i = 0; i < 32; ++i) S[i] = s0[(size_t)(32 * kq + i) * HD + v]; }
        else {
#pragma unroll
            for (int i = 0; i < 32; ++i) S[i] = 0.f; }
        for (int t0 = 0; t0 < L; t0 += 32) {
            const int nt = (L - t0) < 32 ? (L - t0) : 32;
            __syncthreads();
            for (int e = tid; e < nt * 128; e += NTHR) { const int tt = e >> 7, c = e & 127; const size_t o = (size_t)(row0 + t0 + tt) * D + h * HD + c;
                sk[e] = bf2f(Kb[o]); sq[e] = bf2f(Q[o]); sv[e] = bf2f(V[o]); }
            if (tid < nt) { sg[2 * tid] = beta[(size_t)(row0 + t0 + tid) * 8 + h]; sg[2 * tid + 1] = gg[(size_t)(row0 + t0 + tid) * 8 + h]; }
            __syncthreads();
            for (int tt = 0; tt < nt; ++tt) {
                const float bt = sg[2 * tt], dec = __expf(sg[2 * tt + 1]); const int pb = tt & 1;
                float part = 0.f;
#pragma unroll
                for (int i = 0; i < 32; ++i) { S[i] *= dec; part += S[i] * sk[tt * 128 + 32 * kq + i]; }
                red[(pb * 4 + kq) * 128 + v] = part;
                __syncthreads();
                const float kS = (red[(pb * 4 + 0) * 128 + v] + red[(pb * 4 + 1) * 128 + v]) + (red[(pb * 4 + 2) * 128 + v] + red[(pb * 4 + 3) * 128 + v]);
                const float delta = bt * (sv[tt * 128 + v] - kS);
                float op = 0.f;
#pragma unroll
                for (int i = 0; i < 32; ++i) { S[i] += sk[tt * 128 + 32 * kq + i] * delta; op += S[i] * sq[tt * 128 + 32 * kq + i]; }
                red2[(pb * 4 + kq) * 128 + v] = op;
                __syncthreads();
                if (kq == 0) O[(size_t)(row0 + t0 + tt) * D + h * HD + v] = (red2[(pb * 4 + 0) * 128 + v] + red2[(pb * 4 + 1) * 128 + v]) + (red2[(pb * 4 + 2) * 128 + v] + red2[(pb * 4 + 3) * 128 + v]);
            }
        }
        float* so = a->out + (smp ? O_SDNS : O_PDNS) + (((size_t)j * (smp ? NB_S : NB_P) + b) * NH + h) * HD * HD;
#pragma unroll
        for (int i = 0; i < 32; ++i) so[(size_t)(32 * kq + i) * HD + v] = S[i];
    }
}
__device__ __forceinline__ void dn_gate_phase(const Frame& F, KArgs a, int j) {
    bf16_t* proj = (bf16_t*)(a->ws + WS_R1); const float* O = (const float*)(a->ws + WS_R2 + R2_O); const float* ng = a->in[12] + j * HD;
    const int gw = F.vcu * NWAVES + F.wave, NGW = F.G * NWAVES, lane = F.lane;
    const f32x2 nv = *(const f32x2*)(ng + 2 * lane);
    for (int it = gw; it < M * NH; it += NGW) {
        const int r = it >> 3, h = it & 7;
        const f32x2 o = *(const f32x2*)(O + (size_t)r * D + h * HD + 2 * lane);
        const float rs = rsqrtf(wave_sum(o.x * o.x + o.y * o.y) * (1.0f / HD) + RMS_EPS);
        bf16_t* zp = proj + (size_t)r * PROJW + QKV + h * HD + 2 * lane; const unsigned zw = *(const unsigned*)zp;
        *(unsigned*)zp = pk2(o.x * rs * nv.x * siluf_(bf2f(zw & 0xffffu)), o.y * rs * nv.y * siluf_(bf2f(zw >> 16)));
    }
}
__device__ __forceinline__ void sc_act_phase(const Frame& F, KArgs a, int j) {
    bf16_t* proj = (bf16_t*)(a->ws + WS_R1); const float* cw = a->in[15] + (size_t)j * 3 * D; const float* sbuf = a->in[6] + (size_t)j * NB_S * 2 * D;
    const int gw = F.vcu * NWAVES + F.wave, NGW = F.G * NWAVES, lane = F.lane;
    for (int it = gw; it < M * 2; it += NGW) {
        const int r = it >> 1, c0 = (it & 1) * 512 + 8 * lane; int b, t, L; bool smp; row_info(r, b, t, L, smp);
        float y[8];
#pragma unroll
        for (int e = 0; e < 8; ++e) y[e] = 0.f;
#pragma unroll
        for (int jj = 0; jj < 3; ++jj) { const int d = 2 - jj; float u[8];
            if (t - d >= 0) { float cc[8], hh[8]; unpack8(*(const u32x4*)(proj + (size_t)(r - d) * 3072 + 1024 + c0), cc); unpack8(*(const u32x4*)(proj + (size_t)(r - d) * 3072 + 2048 + c0), hh);
#pragma unroll
                for (int e = 0; e < 8; ++e) u[e] = cc[e] * hh[e]; }
            else if (smp) { const float* p = sbuf + ((size_t)b * 2 + (t + jj)) * D + c0;
#pragma unroll
                for (int e = 0; e < 8; ++e) u[e] = p[e]; }
            else {
#pragma unroll
                for (int e = 0; e < 8; ++e) u[e] = 0.f; }
            const float* wp = cw + (size_t)jj * D + c0;
#pragma unroll
            for (int e = 0; e < 8; ++e) y[e] += wp[e] * u[e];
            if (jj == 2 && t >= L - 2) { float* o = a->out + (smp ? O_SSC : O_PSC) + (((size_t)j * (smp ? NB_S : NB_P) + b) * 2 + (t - (L - 2))) * D + c0;
#pragma unroll
                for (int e = 0; e < 8; ++e) o[e] = u[e]; } }
        float bb[8]; bf16_t* bp = proj + (size_t)r * 3072 + c0; unpack8(*(const u32x4*)bp, bb);
#pragma unroll
        for (int e = 0; e < 8; ++e) y[e] *= bb[e];
        *(u32x4*)bp = pack8(y);
    }
}
__device__ __forceinline__ void ffn_act_phase(const Frame& F, KArgs a, int l) {
    const bf16_t* up = (const bf16_t*)(a->ws + WS_R2); bf16_t* act = (bf16_t*)(a->ws + WS_R1);
    const float* cw = a->in[18] + (size_t)l * 3 * DFF2; const float* sbuf = a->in[7] + (size_t)l * NB_S * 2 * DFF2;
    const int gw = F.vcu * NWAVES + F.wave, NGW = F.G * NWAVES, lane = F.lane;
    for (int it = gw; it < M * 6; it += NGW) {
        const int r = it / 6, c0 = (it % 6) * 512 + 8 * lane; if (c0 >= DFF) continue;
        int b, t, L; bool smp; row_info(r, b, t, L, smp);
        float yv[8], yg[8];
#pragma unroll
        for (int e = 0; e < 8; ++e) { yv[e] = 0.f; yg[e] = 0.f; }
#pragma unroll
        for (int jj = 0; jj < 3; ++jj) { const int d = 2 - jj; float uv[8], ug[8];
            if (t - d >= 0) { unpack8(*(const u32x4*)(up + (size_t)(r - d) * DFF2 + c0), uv); unpack8(*(const u32x4*)(up + (size_t)(r - d) * DFF2 + DFF + c0), ug); }
            else if (smp) { const float* p = sbuf + ((size_t)b * 2 + (t + jj)) * DFF2 + c0;
#pragma unroll
                for (int e = 0; e < 8; ++e) { uv[e] = p[e]; ug[e] = p[DFF + e]; } }
            else {
#pragma unroll
                for (int e = 0; e < 8; ++e) { uv[e] = 0.f; ug[e] = 0.f; } }
            const float* wp = cw + (size_t)jj * DFF2 + c0;
#pragma unroll
            for (int e = 0; e < 8; ++e) { yv[e] += wp[e] * uv[e]; yg[e] += wp[DFF + e] * ug[e]; }
            if (jj == 2 && t >= L - 2) { float* o = a->out + (smp ? O_SFFN : O_PFFN) + (((size_t)l * (smp ? NB_S : NB_P) + b) * 2 + (t - (L - 2))) * DFF2 + c0;
#pragma unroll
                for (int e = 0; e < 8; ++e) { o[e] = uv[e]; o[DFF + e] = ug[e]; } } }
#pragma unroll
        for (int e = 0; e < 8; ++e) yv[e] *= siluf_(yg[e]);
        *(u32x4*)(act + (size_t)r * DFF + c0) = pack8(yv);
    }
}

enum Kind { K_P0 = 0, K_PROJ, K_DN_PRE, K_DN_SCAN, K_DN_GATE, K_SC_ACT, K_WOUT, K_UP, K_ACT, K_DOWN, K_GATE };
constexpr int N_PHASES = 1 + 9 + 7 + 9 + 7;
__host__ __device__ __forceinline__ void decode_phase(int p, int& l, int& kind) {
    if (p == 0) { l = 0; kind = K_P0; return; }
    p -= 1; l = 0;
    for (;;) { const int n = (l & 1) ? 7 : 9; if (p < n) break; p -= n; ++l; }
    const unsigned long long dnk = 0xA98764321ull  , sck = 0xA987651ull  ;
    kind = (int)((((l & 1) == 0 ? dnk : sck) >> (4 * p)) & 0xFull);
}

__global__ void __launch_bounds__(NTHR, 2) mk_fwd(Args args) {
    extern __shared__ __attribute__((aligned(16))) unsigned char lds_raw[];
    Frame F; F.lds = (LAS unsigned char*)lds_raw; F.tid = threadIdx.x; F.lane = F.tid & 63; F.wave = __builtin_amdgcn_readfirstlane(F.tid >> 6);
    F.G = gridDim.x; { const int bx = blockIdx.x; F.vcu = (F.G % 8 == 0) ? (bx % 8) * (F.G / 8) + bx / 8 : bx; }
    volatile LAS unsigned* MISC = (volatile LAS unsigned*)(F.lds + MISC_OFF);
    for (int u = F.tid; u < (LDS_BYTES - LDSCTL_OFF) / 4; u += NTHR) ((LAS unsigned*)(F.lds + LDSCTL_OFF))[u] = 0u;
    __syncthreads();
    const int ph_lo = args.ph_lo, ph_hi = args.ph_hi;
    XcdBarrier bar; bar.bar = (unsigned*)(args.ws + WS_CTL) + CW_BAR; bar.x = 0; bar.st = nullptr;
    if (ph_hi - ph_lo > 1) bar = xcd_barrier_post((unsigned*)(args.ws + WS_CTL) + CW_BAR, MISC + 8);
    for (int p = ph_lo; p < ph_hi; ++p) {
        KArgs ka = (KArgs)__builtin_amdgcn_kernarg_segment_ptr(); asm volatile("" : "+s"(ka));
        { int t_ = threadIdx.x; asm volatile("" : "+v"(t_)); F.tid = t_; F.lane = t_ & 63; F.wave = __builtin_amdgcn_readfirstlane(t_ >> 6); }
        int l, kind; decode_phase(p, l, kind);
        const int j = l >> 1; const bool dn = (l & 1) == 0;
        unsigned char* ws = ka->ws;
        switch (kind) {
        case K_P0: p0_prologue(F, ka); break;
        case K_PROJ: {
            const int N = dn ? 4352 : 3072;
            pg8::Gemm g{(const bf16_t*)(ws + ((l & 1) ? WS_X1 : WS_X0)), wl_base(ka, l) + WL_IN, M, N, D, D}; pg8::StaticOrder S; S.init(M, N, F.G, (int)blockIdx.x);
            pg8::EpiBf16 E{(bf16_t*)(ws + WS_R1), dn ? PROJW : 3072, (float*)(ws + WS_BA), dn ? 16 : -1};
            pg8::gemm_phase<pg8::EpiBf16, pg8::StaticOrder>(F.lds, F.tid, g, S, E);
        } break;
        case K_DN_PRE: dn_pre_phase(F, ka, j); break;
        case K_DN_SCAN: dn_scan_naive(F, ka, j); break;
        case K_DN_GATE: dn_gate_phase(F, ka, j); break;
        case K_SC_ACT: sc_act_phase(F, ka, j); break;
        case K_WOUT: {
            const bf16_t* R1 = (const bf16_t*)(ws + WS_R1);
            pg8::Gemm g{dn ? R1 + QKV : R1, wl_base(ka, l) + WL_OUT, M, D, D, dn ? PROJW : 3072}; pg8::StaticOrder S; S.init(M, D, F.G, (int)blockIdx.x);
            pg8::EpiResStats E{(bf16_t*)(ws + ((l & 1) ? WS_X1 : WS_X0)), (float*)(ws + WS_ST1)};
            pg8::gemm_phase<pg8::EpiResStats, pg8::StaticOrder>(F.lds, F.tid, g, S, E);
        } break;
        case K_UP: {
            const float* vb = vec_base(ka, l);
            pg8::Gemm g{(const bf16_t*)(ws + ((l & 1) ? WS_X1 : WS_X0)), wl_base(ka, l) + WL_UP, M, DFF2, D, D}; pg8::StaticOrder S; S.init(M, DFF2, F.G, (int)blockIdx.x);
            pg8::EpiLnFold E{(bf16_t*)(ws + WS_R2), DFF2, (const float*)(ws + WS_ST1), vb, vb + DFF2};
            pg8::gemm_phase<pg8::EpiLnFold, pg8::StaticOrder>(F.lds, F.tid, g, S, E);
        } break;
        case K_ACT: {
            ffn_act_phase(F, ka, l);
            pg8::Gemm g{(const bf16_t*)(ws + WS_PB) + (size_t)l * M * DPLE, wl_base(ka, l) + WL_P, M, D, DPLE, DPLE}; pg8::StaticOrder S; S.init(M, D, F.G, (int)blockIdx.x);
            pg8::EpiBf16 E{(bf16_t*)(ws + WS_R1) + (size_t)M * DFF, D, nullptr, -1};
            pg8::gemm_phase<pg8::EpiBf16, pg8::StaticOrder>(F.lds, F.tid, g, S, E);
        } break;
        case K_DOWN: {
            pg8::Gemm g{(const bf16_t*)(ws + WS_R1), wl_base(ka, l) + WL_DOWN, M, D, DFF, DFF}; pg8::StaticOrder S; S.init(M, D, F.G, (int)blockIdx.x);
            pg8::EpiLnResStats E{(bf16_t*)(ws + ((l & 1) ? WS_X1 : WS_X0)), (const float*)(ws + WS_ST1), (float*)(ws + WS_ST2), ka->in[20] + l * D, ka->in[21] + l * D};
            pg8::gemm_phase<pg8::EpiLnResStats, pg8::StaticOrder>(F.lds, F.tid, g, S, E);
        } break;
        case K_GATE: {
            const float* vb = vec_base(ka, l);
            const bf16_t* Xc = (const bf16_t*)(ws + ((l & 1) ? WS_X1 : WS_X0));
            pg8::Gemm g{Xc, wl_base(ka, l) + WL_G, M, D, D, D}; pg8::StaticOrder S; S.init(M, D, F.G, (int)blockIdx.x);
            pg8::EpiGate E{Xc, (const bf16_t*)(ws + WS_R1) + (size_t)M * DFF, (bf16_t*)(ws + ((l & 1) ? WS_X0 : WS_X1)), l == DEPTH - 1 ? ka->out + O_Y : nullptr, (const float*)(ws + WS_ST2),
                           vb + 2 * DFF2, vb + 2 * DFF2 + D, ka->in[22] + l * D, ka->in[23] + l * D};
            pg8::gemm_phase<pg8::EpiGate, pg8::StaticOrder>(F.lds, F.tid, g, S, E);
        } break;
        default: break;
        }
        if (p + 1 < ph_hi) xcd_barrier(bar);
    }
}

extern "C" void kernel_launch(void* const* d_in, const int* in_sizes, int n_in, void* d_out, int out_size, void* d_ws, size_t ws_size, hipStream_t stream) {
    static int grid = 0;
    if (grid == 0) {
        if (n_in != 26 || out_size != (int)O_END || ws_size < WS_END) { fprintf(stderr, "kernel_launch: unexpected shapes (n_in %d, out %d, ws %zu; need ws >= %zu)\n", n_in, out_size, ws_size, (size_t)WS_END); grid = -1; return; }
        int dev = 0, cus = 0;
        if (hipGetDevice(&dev) != hipSuccess || hipDeviceGetAttribute(&cus, hipDeviceAttributeMultiprocessorCount, dev) != hipSuccess) { grid = -1; return; }
        if (hipFuncSetAttribute((const void*)mk_fwd, hipFuncAttributeMaxDynamicSharedMemorySize, LDS_BYTES) != hipSuccess) { fprintf(stderr, "kernel_launch: hipFuncSetAttribute failed\n"); grid = -1; return; }
        int per_cu = 0; (void)hipOccupancyMaxActiveBlocksPerMultiprocessor(&per_cu, (const void*)mk_fwd, NTHR, LDS_BYTES); (void)hipGetLastError();
        grid = cus;
    }
    if (grid < 0) return;
    (void)hipMemsetAsync((char*)d_ws + WS_CTL, 0, CTL_ZERO_BYTES, stream);
    Args a{};
    for (int i = 0; i < 26; ++i) a.in[i] = (const float*)d_in[i];
    a.out = (float*)d_out; a.ws = (unsigned char*)d_ws;
#if MK_PER_PHASE_LAUNCH
    for (int p = 0; p < N_PHASES; ++p) { a.ph_lo = p; a.ph_hi = p + 1; hipLaunchKernelGGL(mk_fwd, dim3(grid), dim3(NTHR), LDS_BYTES, stream, a); }
#else
    a.ph_lo = 0; a.ph_hi = N_PHASES; hipLaunchKernelGGL(mk_fwd, dim3(grid), dim3(NTHR), LDS_BYTES, stream, a);
#endif
}
```

```cpp
#include <hip/hip_runtime.h>
#include <cstdio>
#include <cstdint>

#ifndef MK_PER_PHASE_LAUNCH
#define MK_PER_PHASE_LAUNCH 0
#endif

#define LAS __attribute__((address_space(3)))
#define GAS __attribute__((address_space(1)))
typedef unsigned short bf16_t;
typedef short bf16x8 __attribute__((ext_vector_type(8)));
typedef float f32x4 __attribute__((ext_vector_type(4)));
typedef float f32x2 __attribute__((ext_vector_type(2)));
typedef unsigned u32x4 __attribute__((ext_vector_type(4)));
typedef unsigned u32x2 __attribute__((ext_vector_type(2)));

constexpr int D = 1024, M_P = 16384, M_S = 1024, M = M_P + M_S, SEQ = 2048, DSEQ = 8, NB_P = 8, NB_S = 128;
constexpr int NH = 8, HD = 128, QKV = 3072, AIN = 4112, PROJW = 4096, DFF = 2816, DFF2 = 5632, DPLE = 256, DEPTH = 4;
constexpr float ALPHA = 1.6817928305074290f;
constexpr float LN_EPS = 1e-5f, RMS_EPS = 1e-6f, L2_EPS = 1e-6f;
constexpr float QSCALE = 0.08838834764831845f;

constexpr size_t O_Y = 0, O_PDNC = 17825792, O_PDNS = O_PDNC + 147456, O_PSC = O_PDNS + 2097152, O_PFFN = O_PSC + 32768,
                 O_SDNC = O_PFFN + 360448, O_SDNS = O_SDNC + 2359296, O_SSC = O_SDNS + 33554432, O_SFFN = O_SSC + 524288, O_END = O_SFFN + 5767168;

constexpr size_t WL_IN = 0, WL_OUT = WL_IN + (size_t)4352 * 1024, WL_UP = WL_OUT + (size_t)1024 * 1024, WL_DOWN = WL_UP + (size_t)DFF2 * 1024,
                 WL_G = WL_DOWN + (size_t)1024 * DFF, WL_P = WL_G + (size_t)1024 * 1024, WL_SIZE = WL_P + (size_t)1024 * 256;
constexpr size_t MiB = 1u << 20;
constexpr size_t WS_CTL = 0, CTL_ZERO_BYTES = 1 * MiB;
constexpr size_t WS_VEC = 1 * MiB;
constexpr size_t VEC_L = 2 * DFF2 + 2 * 1024;
constexpr size_t WS_BA = 2 * MiB;
constexpr size_t WS_GATES = WS_BA + (size_t)M * 16 * 4 + 65536;
constexpr size_t WS_ST1 = 5 * MiB, WS_ST2 = 8 * MiB;
constexpr size_t WS_W23 = 11 * MiB;
constexpr size_t WS_X0 = WS_W23 + 2 * WL_SIZE * 2;
constexpr size_t WS_X1 = WS_X0 + (size_t)M * D * 2;
constexpr size_t WS_PB = WS_X1 + (size_t)M * D * 2;
constexpr size_t WS_R1 = WS_PB + (size_t)4 * M * DPLE * 2;
constexpr size_t WS_R2 = WS_R1 + (size_t)M * PROJW * 2;
constexpr size_t WS_END = WS_R2 + (size_t)M * DFF2 * 2;
static_assert(WS_END <= (size_t)520 * MiB, "workspace budget");
constexpr int CU_WF = 0, CU_QF = 16384, CU_KF = 32768, CU_AF = 49152, CU_U = 55296, CU_BYTES = 88064, CU_LDS = 55296, N_CU = NB_P * NH * 32;
constexpr size_t R2_DEC = (size_t)N_CU * CU_BYTES;
static_assert(R2_DEC + N_CU * 4 <= (size_t)M * DFF2 * 2, "chunk intermediates fit in R2");
constexpr int OLD = 2048;
constexpr size_t R2_OS = R2_DEC + 65536;
static_assert(R2_OS + (size_t)M_S * D * 4 <= (size_t)M * DFF2 * 2, "sample o fits in R2");

__device__ __forceinline__ float bf2f(unsigned b) { return __uint_as_float(b << 16); }
__device__ __forceinline__ unsigned f2bf(float f) { unsigned u = __float_as_uint(f); return (u + 0x7fffu + ((u >> 16) & 1u)) >> 16; }
__device__ __forceinline__ unsigned pk2(float lo, float hi) { return f2bf(lo) | (f2bf(hi) << 16); }
typedef __bf16 bf16x2_t __attribute__((ext_vector_type(2)));
__device__ __forceinline__ unsigned cvtpk(float lo, float hi) { f32x2 v = {lo, hi}; bf16x2_t b = __builtin_convertvector(v, bf16x2_t); return __builtin_bit_cast(unsigned, b); }
__device__ __forceinline__ int crow(int reg, int hh) { return (reg & 3) + 8 * (reg >> 2) + 4 * hh; }
typedef float f32x16 __attribute__((ext_vector_type(16)));
__device__ __forceinline__ float sigmoidf_(float x) { return 1.0f / (1.0f + __expf(-x)); }
__device__ __forceinline__ float siluf_(float x) { return x / (1.0f + __expf(-x)); }
__device__ __forceinline__ void unpack8(const u32x4 w, float (&f)[8]) {
    f[0] = __uint_as_float(w.x << 16); f[1] = __uint_as_float(w.x & 0xffff0000u); f[2] = __uint_as_float(w.y << 16); f[3] = __uint_as_float(w.y & 0xffff0000u);
    f[4] = __uint_as_float(w.z << 16); f[5] = __uint_as_float(w.z & 0xffff0000u); f[6] = __uint_as_float(w.w << 16); f[7] = __uint_as_float(w.w & 0xffff0000u);
}
__device__ __forceinline__ u32x4 pack8(const float (&f)[8]) { u32x4 w; w.x = pk2(f[0], f[1]); w.y = pk2(f[2], f[3]); w.z = pk2(f[4], f[5]); w.w = pk2(f[6], f[7]); return w; }
__device__ __forceinline__ float wave_sum(float v) {
#pragma unroll
    for (int o = 1; o < 64; o <<= 1) v += __shfl_xor(v, o);
    return v;
}
__device__ __forceinline__ void row_info(int r, int& b, int& t, int& L, bool& smp) {
    if (r < M_P) { b = r >> 11; t = r & 2047; L = SEQ; smp = false; } else { const int q = r - M_P; b = q >> 3; t = q & 7; L = DSEQ; smp = true; }
}

namespace pg8 {
constexpr int BM = 256, BK = 64, HALF = 128, HTB = HALF * BK * 2, STAGE_BYTES = 8 * HTB, NXCD = 8, WGM = 8;
__host__ __device__ __forceinline__ int lds_byte(int r, int c) { const int st = (r >> 4) * 2 + (c >> 5), rr = r & 15, cc = c & 31, ob = rr * 64 + cc * 2; return st * 1024 + (ob ^ (((ob >> 9) & 1) << 5)); }
__host__ __device__ __forceinline__ void stage_rc(int b, int& R, int& C) { const int st = b / 1024, sb = b % 1024, swz = sb ^ (((sb >> 9) & 1) << 5); R = (st >> 1) * 16 + swz / 64; C = (st & 1) * 32 + (swz % 64) / 2; }
__host__ __device__ __forceinline__ int perm32(int rho) { const int n = rho >> 4, i = rho & 15; return 8 * (i >> 2) + 4 * n + (i & 3); }

struct Unit { int pm, pn; };
struct Gemm { const bf16_t* A; const bf16_t* Bt; int M, N, K, lda; };

struct StaticOrder {
    int nM, nN, nwg, G, c;
    __host__ __device__ void init(int M_, int N_, int G_, int c_) { nM = M_ / BM; nN = N_ / BM; nwg = nM * nN; G = G_; c = c_; }
    __host__ __device__ bool next(int i, Unit& u) const {
        const long L = (long)i * G + c; if (L >= nwg) return false;
        int wgid = (int)L; { const int q = nwg / NXCD, r = nwg % NXCD, xcd = wgid % NXCD, off = wgid / NXCD; wgid = (xcd < r ? xcd * (q + 1) : r * (q + 1) + (xcd - r) * q) + off; }
        const int nig = WGM * nN, gid = wgid / nig, fm = gid * WGM, gsz = (nM - fm) < WGM ? (nM - fm) : WGM;
        u.pm = fm + ((wgid % nig) % gsz); u.pn = (wgid % nig) / gsz; return true;
    }
    __device__ __forceinline__ void a_ready(const Unit&) const {}
    __device__ __forceinline__ void done(const Unit&) const {}
};

typedef f32x4 Acc[2][2][4][2];

__device__ __forceinline__ void row_stats(const float* st  , int row, int fq, float& mu, float& rstd) {
    const f32x4* p = (const f32x4*)(st + (size_t)row * 32 + 8 * fq);
    const f32x4 a = p[0], b = p[1];
    float s = (a.x + a.z) + (b.x + b.z), q = (a.y + a.w) + (b.y + b.w);
    s += __shfl_xor(s, 16); s += __shfl_xor(s, 32); q += __shfl_xor(q, 16); q += __shfl_xor(q, 32);
    mu = s * (1.0f / 1024.0f); const float var = fmaxf(q * (1.0f / 1024.0f) - mu * mu, 0.f); rstd = rsqrtf(var + LN_EPS);
}

struct EpiBf16 {
    static constexpr bool PERM = true;
    bf16_t* O; int ldc; float* ba; int ba_pn;
    __device__ __forceinline__ void operator()(const Acc& acc, const Unit& u, int wr, int wc, int fr, int fq) const {
        const int row0 = u.pm * BM + wr * 64 + fr;
        if (u.pn == ba_pn) {
            if (wc == 0 && fq < 2) {
#pragma unroll
                for (int ai = 0; ai < 2; ++ai)
#pragma unroll
                    for (int m = 0; m < 4; ++m) { float* p = ba + (size_t)(row0 + ai * HALF + m * 16) * 16 + 8 * fq; *(f32x4*)p = acc[ai][0][m][0]; *(f32x4*)(p + 4) = acc[ai][0][m][1]; }
            }
            return;
        }
        const int col0 = u.pn * BM + wc * 32 + 8 * fq;
#pragma unroll
        for (int ai = 0; ai < 2; ++ai)
#pragma unroll
            for (int m = 0; m < 4; ++m) { bf16_t* rowp = O + (size_t)(row0 + ai * HALF + m * 16) * ldc + col0;
#pragma unroll
                for (int bj = 0; bj < 2; ++bj) { const f32x4 v0 = acc[ai][bj][m][0], v1 = acc[ai][bj][m][1];
                    u32x4 w; w.x = pk2(v0[0], v0[1]); w.y = pk2(v0[2], v0[3]); w.z = pk2(v1[0], v1[1]); w.w = pk2(v1[2], v1[3]);
                    *(u32x4*)(rowp + bj * HALF) = w; } }
    }
};
struct EpiResStats {
    static constexpr bool PERM = true;
    bf16_t* X; float* st;
    __device__ __forceinline__ void operator()(const Acc& acc, const Unit& u, int wr, int wc, int fr, int fq) const {
        const int row0 = u.pm * BM + wr * 64 + fr, col0 = u.pn * BM + wc * 32 + 8 * fq;
#pragma unroll
        for (int ai = 0; ai < 2; ++ai)
#pragma unroll
            for (int m = 0; m < 4; ++m) { const int row = row0 + ai * HALF + m * 16; bf16_t* rowp = X + (size_t)row * D + col0; float s = 0.f, q = 0.f;
#pragma unroll
                for (int bj = 0; bj < 2; ++bj) { float x[8]; unpack8(*(const u32x4*)(rowp + bj * HALF), x); const f32x4 v0 = acc[ai][bj][m][0], v1 = acc[ai][bj][m][1];
#pragma unroll
                    for (int e = 0; e < 4; ++e) { x[e] = ALPHA * x[e] + v0[e]; x[4 + e] = ALPHA * x[4 + e] + v1[e]; }
#pragma unroll
                    for (int e = 0; e < 8; ++e) { s += x[e]; q += x[e] * x[e]; }
                    *(u32x4*)(rowp + bj * HALF) = pack8(x); }
                s += __shfl_xor(s, 16); s += __shfl_xor(s, 32); q += __shfl_xor(q, 16); q += __shfl_xor(q, 32);
                if (fq == 0) *(f32x2*)(st + ((size_t)row * 16 + u.pn * 4 + wc) * 2) = (f32x2){s, q}; }
    }
};
struct EpiLnResStats {
    static constexpr bool PERM = true;
    bf16_t* X; const float* st_in; float* st_out; const float* g; const float* b;
    __device__ __forceinline__ void operator()(const Acc& acc, const Unit& u, int wr, int wc, int fr, int fq) const {
        const int row0 = u.pm * BM + wr * 64 + fr, col0 = u.pn * BM + wc * 32 + 8 * fq;
        f32x4 gv[2][2], bv[2][2];
#pragma unroll
        for (int bj = 0; bj < 2; ++bj)
#pragma unroll
            for (int n = 0; n < 2; ++n) { gv[bj][n] = *(const f32x4*)(g + col0 + bj * HALF + 4 * n); bv[bj][n] = *(const f32x4*)(b + col0 + bj * HALF + 4 * n); }
#pragma unroll
        for (int ai = 0; ai < 2; ++ai)
#pragma unroll
            for (int m = 0; m < 4; ++m) { const int row = row0 + ai * HALF + m * 16; bf16_t* rowp = X + (size_t)row * D + col0; float s = 0.f, q = 0.f;
                float mu, rs; row_stats(st_in, row, fq, mu, rs);
#pragma unroll
                for (int bj = 0; bj < 2; ++bj) { float x[8]; unpack8(*(const u32x4*)(rowp + bj * HALF), x); const f32x4 v0 = acc[ai][bj][m][0], v1 = acc[ai][bj][m][1];
#pragma unroll
                    for (int e = 0; e < 4; ++e) { x[e] = ALPHA * ((x[e] - mu) * rs * gv[bj][0][e] + bv[bj][0][e]) + v0[e]; x[4 + e] = ALPHA * ((x[4 + e] - mu) * rs * gv[bj][1][e] + bv[bj][1][e]) + v1[e]; }
#pragma unroll
                    for (int e = 0; e < 8; ++e) { s += x[e]; q += x[e] * x[e]; }
                    *(u32x4*)(rowp + bj * HALF) = pack8(x); }
                s += __shfl_xor(s, 16); s += __shfl_xor(s, 32); q += __shfl_xor(q, 16); q += __shfl_xor(q, 32);
                if (fq == 0) *(f32x2*)(st_out + ((size_t)row * 16 + u.pn * 4 + wc) * 2) = (f32x2){s, q}; }
    }
};
struct EpiLnFold {
    static constexpr bool PERM = true;
    bf16_t* O; int ldc; const float* st; const float* c1; const float* c2;
    __device__ __forceinline__ void operator()(const Acc& acc, const Unit& u, int wr, int wc, int fr, int fq) const {
        const int row0 = u.pm * BM + wr * 64 + fr, col0 = u.pn * BM + wc * 32 + 8 * fq;
        f32x4 c1v[2][2], c2v[2][2];
#pragma unroll
        for (int bj = 0; bj < 2; ++bj)
#pragma unroll
            for (int n = 0; n < 2; ++n) { c1v[bj][n] = *(const f32x4*)(c1 + col0 + bj * HALF + 4 * n); c2v[bj][n] = *(const f32x4*)(c2 + col0 + bj * HALF + 4 * n); }
#pragma unroll
        for (int ai = 0; ai < 2; ++ai)
#pragma unroll
            for (int m = 0; m < 4; ++m) { const int row = row0 + ai * HALF + m * 16; bf16_t* rowp = O + (size_t)row * ldc + col0;
                float mu, rs; row_stats(st, row, fq, mu, rs);
#pragma unroll
                for (int bj = 0; bj < 2; ++bj) { const f32x4 v0 = (acc[ai][bj][m][0] - mu * c1v[bj][0]) * rs + c2v[bj][0], v1 = (acc[ai][bj][m][1] - mu * c1v[bj][1]) * rs + c2v[bj][1];
                    u32x4 w; w.x = pk2(v0[0], v0[1]); w.y = pk2(v0[2], v0[3]); w.z = pk2(v1[0], v1[1]); w.w = pk2(v1[2], v1[3]);
                    *(u32x4*)(rowp + bj * HALF) = w; } }
    }
};
struct EpiGate {
    static constexpr bool PERM = true;
    const bf16_t* H; const bf16_t* PP; bf16_t* XO; float* Y; const float* st; const float* c1; const float* c2; const float* g; const float* b;
    __device__ __forceinline__ void operator()(const Acc& acc, const Unit& u, int wr, int wc, int fr, int fq) const {
        const int row0 = u.pm * BM + wr * 64 + fr, col0 = u.pn * BM + wc * 32 + 8 * fq;
#pragma unroll
        for (int ai = 0; ai < 2; ++ai)
#pragma unroll
            for (int m = 0; m < 4; ++m) { const int row = row0 + ai * HALF + m * 16; const size_t off = (size_t)row * D + col0;
                float mu, rs; row_stats(st, row, fq, mu, rs);
#pragma unroll
                for (int bj = 0; bj < 2; ++bj) { float h[8], pp[8], o[8]; unpack8(*(const u32x4*)(H + off + bj * HALF), h); unpack8(*(const u32x4*)(PP + off + bj * HALF), pp);
#pragma unroll
                    for (int n = 0; n < 2; ++n) { const int cc = col0 + bj * HALF + 4 * n; const f32x4 c1v = *(const f32x4*)(c1 + cc), c2v = *(const f32x4*)(c2 + cc), gv = *(const f32x4*)(g + cc), bv = *(const f32x4*)(b + cc);
#pragma unroll
                        for (int e = 0; e < 4; ++e) { const float gate = (acc[ai][bj][m][n][e] - mu * c1v[e]) * rs + c2v[e]; const float x2 = (h[4 * n + e] - mu) * rs * gv[e] + bv[e];
                            o[4 * n + e] = x2 + pp[4 * n + e] * sigmoidf_(gate); } }
                    *(u32x4*)(XO + off + bj * HALF) = pack8(o);
                    if (Y) { *(f32x4*)(Y + off + bj * HALF) = (f32x4){o[0], o[1], o[2], o[3]}; *(f32x4*)(Y + off + bj * HALF + 4) = (f32x4){o[4], o[5], o[6], o[7]}; } } }
    }
};

template <class Epi, class Sched, bool ALIGN_EPI = true>
__device__ __forceinline__ void gemm_phase(LAS unsigned char* lds, const int tid, const Gemm g, const Sched& S, const Epi& E) {
    const int wid = __builtin_amdgcn_readfirstlane(tid >> 6), lane = tid & 63, wr = wid >> 2, wc = wid & 3, fr = lane & 15, fq = lane >> 4;
    const int K = g.K, nt = K / BK, lda = g.lda;
    unsigned voffA[2], voffB[2];
#pragma unroll
    for (int i = 0; i < 2; ++i) { int R, C; stage_rc(tid * 16 + i * 8192, R, C); const int Rb = Epi::PERM ? ((R & ~31) + perm32(R & 31)) : R;
        voffA[i] = (unsigned)(R * lda + C) * 2u; voffB[i] = (unsigned)(Rb * K + C) * 2u; }
    const size_t kstep = (size_t)(BK * 2);
    const size_t hstepA = (size_t)HALF * lda * 2, hstepB = (size_t)HALF * K * 2;
    const size_t tstepA = 2 * hstepA, tstepB = 2 * hstepB;
    const unsigned ldsw = (unsigned)wid * 1024u;
    const int aoff = lds_byte(wr * 64 + fr, fq * 8), boff = lds_byte(wc * 32 + fr, fq * 8);
#define PG8_SA(b, h) (((b) * 2 + (h)) * HTB)
#define PG8_SB(b, h) ((4 + (b) * 2 + (h)) * HTB)
#define PG8_STAGE(bufoff, gbase, voff) do { _Pragma("unroll") for (int _i = 0; _i < 2; ++_i) \
        __builtin_amdgcn_global_load_lds((const unsigned*)((const char*)(gbase) + (voff)[_i]), (LAS unsigned*)(lds + (bufoff) + ldsw + _i * 8192), 16, 0, 0); } while (0)
#define PG8_LDA(dst, b, h) do { _Pragma("unroll") for (int m = 0; m < 4; ++m) _Pragma("unroll") for (int k = 0; k < 2; ++k) dst[m][k] = *(const LAS bf16x8*)(lds + PG8_SA(b, h) + aoff + m * 2048 + k * 1024); } while (0)
#define PG8_LDB(dst, b, h) do { _Pragma("unroll") for (int n = 0; n < 2; ++n) _Pragma("unroll") for (int k = 0; k < 2; ++k) dst[n][k] = *(const LAS bf16x8*)(lds + PG8_SB(b, h) + boff + n * 2048 + k * 1024); } while (0)
#define PG8_MMA(ai, bj, At, Bt) do { __builtin_amdgcn_s_setprio(1); _Pragma("unroll") for (int m = 0; m < 4; ++m) _Pragma("unroll") for (int n = 0; n < 2; ++n) _Pragma("unroll") for (int k = 0; k < 2; ++k) \
        acc[ai][bj][m][n] = __builtin_amdgcn_mfma_f32_16x16x32_bf16(Bt[n][k], At[m][k], acc[ai][bj][m][n], 0, 0, 0); __builtin_amdgcn_s_setprio(0); } while (0)
#define PG8_WAIT_V(n) asm volatile("s_waitcnt vmcnt(" #n ")" ::: "memory")
#define PG8_WAIT_L(n) asm volatile("s_waitcnt lgkmcnt(" #n ")" ::: "memory")
#define PG8_BAR __builtin_amdgcn_s_barrier()
#define PG8_SCHED __builtin_amdgcn_sched_barrier(0)
    Unit cur, nxt; int ui = 0;
    if (!S.next(0, cur)) return;
    f32x4 acc[2][2][4][2];
#pragma unroll
    for (int a = 0; a < 2; ++a)
#pragma unroll
        for (int b = 0; b < 2; ++b)
#pragma unroll
            for (int m = 0; m < 4; ++m)
#pragma unroll
                for (int n = 0; n < 2; ++n) acc[a][b][m][n] = (f32x4){0.f, 0.f, 0.f, 0.f};
    bf16x8 At[4][2], B0[2][2], B1[2][2];
    const char* cA = (const char*)g.A + (size_t)cur.pm * tstepA; const char* cB = (const char*)g.Bt + (size_t)cur.pn * tstepB;
    S.a_ready(cur);
    PG8_STAGE(PG8_SB(0, 0), cB, voffB); PG8_STAGE(PG8_SB(0, 1), cB + hstepB, voffB); PG8_STAGE(PG8_SA(0, 0), cA, voffA); PG8_STAGE(PG8_SA(0, 1), cA + hstepA, voffA);
    if (wr == 1) PG8_BAR;
    PG8_WAIT_V(2); PG8_BAR;
    PG8_STAGE(PG8_SB(1, 0), cB + kstep, voffB); PG8_STAGE(PG8_SA(1, 0), cA + kstep, voffA); PG8_STAGE(PG8_SB(1, 1), cB + hstepB + kstep, voffB);
    PG8_WAIT_V(6); PG8_BAR;
    for (;;) {
        const bool has_next = S.next(ui + 1, nxt);
        const char* nA = has_next ? (const char*)g.A + (size_t)nxt.pm * tstepA : cA; const char* nB = has_next ? (const char*)g.Bt + (size_t)nxt.pn * tstepB : cB;
        for (int t = 0; t < nt; t += 2) {
            const bool last = (t == nt - 2);
            const char* a1 = cA + (size_t)(t + 1) * kstep;
            const char* a2 = last ? nA : cA + (size_t)(t + 2) * kstep; const char* b2 = last ? nB : cB + (size_t)(t + 2) * kstep;
            const char* a3 = a2 + kstep; const char* b3 = b2 + kstep;
            if (last && has_next) S.a_ready(nxt);
            PG8_LDB(B0, 0, 0); PG8_LDB(B1, 0, 1); PG8_SCHED; PG8_LDA(At, 0, 0); PG8_STAGE(PG8_SA(1, 1), a1 + hstepA, voffA);
            PG8_WAIT_V(8); PG8_WAIT_L(0); PG8_BAR; PG8_MMA(0, 0, At, B0); PG8_MMA(0, 1, At, B1); PG8_BAR; PG8_SCHED;
            PG8_LDA(At, 0, 1); PG8_STAGE(PG8_SB(0, 0), b2, voffB); PG8_STAGE(PG8_SB(0, 1), b2 + hstepB, voffB); PG8_STAGE(PG8_SA(0, 0), a2, voffA);
            PG8_WAIT_V(8); PG8_WAIT_L(0); PG8_BAR; PG8_MMA(1, 0, At, B0); PG8_MMA(1, 1, At, B1); PG8_BAR; PG8_SCHED;
            PG8_LDB(B0, 1, 0); PG8_LDB(B1, 1, 1); PG8_SCHED; PG8_LDA(At, 1, 0); PG8_STAGE(PG8_SA(0, 1), a2 + hstepA, voffA);
            PG8_WAIT_V(8); PG8_WAIT_L(0); PG8_BAR; PG8_MMA(0, 0, At, B0); PG8_MMA(0, 1, At, B1); PG8_BAR; PG8_SCHED;
            PG8_LDA(At, 1, 1); PG8_STAGE(PG8_SB(1, 0), b3, voffB); PG8_STAGE(PG8_SB(1, 1), b3 + hstepB, voffB); PG8_STAGE(PG8_SA(1, 0), a3, voffA);
            PG8_WAIT_V(8); PG8_WAIT_L(0); PG8_BAR; PG8_MMA(1, 0, At, B0); PG8_MMA(1, 1, At, B1); PG8_BAR; PG8_SCHED;
        }
        if constexpr (ALIGN_EPI) { if (wr == 0) PG8_BAR; }
        E(acc, cur, wr, wc, fr, fq); S.done(cur);
        if (!has_next) break;
#pragma unroll
        for (int a = 0; a < 2; ++a)
#pragma unroll
            for (int b = 0; b < 2; ++b)
#pragma unroll
                for (int m = 0; m < 4; ++m)
#pragma unroll
                    for (int n = 0; n < 2; ++n) acc[a][b][m][n] = (f32x4){0.f, 0.f, 0.f, 0.f};
        cur = nxt; cA = nA; cB = nB; ++ui;
        if constexpr (ALIGN_EPI) { if (wr == 1) PG8_BAR; }
    }
    PG8_WAIT_V(0);
    if constexpr (!ALIGN_EPI) { if (wr == 0) PG8_BAR; }
    PG8_BAR;
#undef PG8_SA
#undef PG8_SB
#undef PG8_STAGE
#undef PG8_LDA
#undef PG8_LDB
#undef PG8_MMA
#undef PG8_WAIT_V
#undef PG8_WAIT_L
#undef PG8_BAR
#undef PG8_SCHED
}
}

constexpr int NWAVES = 8, NTHR = NWAVES * 64;
constexpr int RING_BYTES = 131072, LDSCTL_OFF = RING_BYTES, MISC_OFF = LDSCTL_OFF + 320, LDS_BYTES = 147456;
typedef GAS unsigned gu32;
#define RLX_AGENT __ATOMIC_RELAXED, __HIP_MEMORY_SCOPE_AGENT

#define XB_TMO      128
#define XB_XCNT(j)  (256  + 64 * (j))
#define XB_XSUB(j)  (1280 + 64 * (j))
#define XB_XGEN(j)  (2304 + 64 * (j))
#define XB_TOP      3328
#define XB_TOPGEN   3392
#define XCD_BAR_WORDS 3456
#define XB_SPIN_CAP (1u << 18)
constexpr int CW_BAR = 4096;
__device__ __forceinline__ unsigned xb_ld(unsigned* p)              { return __hip_atomic_load(p, __ATOMIC_RELAXED, __HIP_MEMORY_SCOPE_AGENT); }
__device__ __forceinline__ unsigned xb_add(unsigned* p, unsigned v) { return __hip_atomic_fetch_add(p, v, __ATOMIC_RELAXED, __HIP_MEMORY_SCOPE_AGENT); }
__device__ __forceinline__ unsigned xb_xcc_id() { return (unsigned)__builtin_amdgcn_s_getreg((3 << 11) | 20) & 0xFu; }
#define XB_SPIN(cond, bar) do { unsigned _sp = 0; while (cond) { __builtin_amdgcn_s_sleep(1); \
    if ((++_sp & 255u) == 0u) { if (xb_ld(&(bar)[XB_TMO])) break; if (_sp > XB_SPIN_CAP) { atomicAdd(&(bar)[XB_TMO], 1u); break; } } } } while (0)
struct XcdBarrier { unsigned* bar; unsigned x; volatile LAS unsigned* st; };
__device__ __forceinline__ XcdBarrier xcd_barrier_post(unsigned* bar, volatile LAS unsigned* st) {
    XcdBarrier b; b.bar = bar; b.x = xb_xcc_id(); b.st = st;
    if (threadIdx.x == 0) (void)xb_add(&bar[XB_XCNT(b.x)], 1u);
    return b;
}
__device__ __forceinline__ void xcd_barrier_complete(unsigned* bar, unsigned x, unsigned& nloc, unsigned& nx) {
    const unsigned G = gridDim.x * gridDim.y * gridDim.z;
    unsigned sum, cnt, mine, sp = 0u;
    for (;;) {
        sum = 0u; cnt = 0u; mine = 0u;
#pragma unroll
        for (unsigned j = 0; j < 16; ++j) { const unsigned c = xb_ld(&bar[XB_XCNT(j)]); sum += c; cnt += (c > 0u) ? 1u : 0u; mine = (j == x) ? c : mine; }
        if (sum == G) break;
        __builtin_amdgcn_s_sleep(1);
        if ((++sp & 255u) == 0u) { if (xb_ld(&bar[XB_TMO])) break; if (sp > XB_SPIN_CAP) { atomicAdd(&bar[XB_TMO], 1u); break; } }
    }
    nloc = mine > 0u ? mine : 1u; nx = cnt > 0u ? cnt : 1u;
}
__device__ __forceinline__ void xcd_barrier(const XcdBarrier& b) {
    asm volatile("s_waitcnt vmcnt(0)" ::: "memory");
    __syncthreads();
    if (threadIdx.x == 0) {
        unsigned* bar = b.bar;
        __builtin_amdgcn_s_waitcnt(0);
        unsigned nloc = b.st[0], nx = b.st[1];
        if (nloc == 0u) { xcd_barrier_complete(bar, b.x, nloc, nx); b.st[0] = nloc; b.st[1] = nx; }
        const unsigned old = xb_add(&bar[XB_XSUB(b.x)], 1u);
        const unsigned gen = old / nloc;
        if (old + 1u == (gen + 1u) * nloc) {
            __builtin_amdgcn_fence(__ATOMIC_RELEASE, "agent");
            asm volatile("s_waitcnt vmcnt(0)" ::: "memory");
            const unsigned og = xb_add(&bar[XB_TOP], 1u);
            const unsigned tg = og / nx;
            if (og + 1u == (tg + 1u) * nx) xb_add(&bar[XB_TOPGEN], 1u);
            else XB_SPIN(xb_ld(&bar[XB_TOPGEN]) == tg, bar);
            __builtin_amdgcn_fence(__ATOMIC_ACQUIRE, "agent");
            xb_add(&bar[XB_XGEN(b.x)], 1u);
            asm volatile("s_waitcnt vmcnt(0)" ::: "memory");
        } else {
            XB_SPIN(xb_ld(&bar[XB_XGEN(b.x)]) == gen, bar);
            __builtin_amdgcn_fence(__ATOMIC_ACQUIRE, "agent");
            asm volatile("s_waitcnt vmcnt(0)" ::: "memory");
        }
    }
    __syncthreads();
}

struct Args {
    const float* in[26]; float* out; unsigned char* ws; int ph_lo, ph_hi;
};
struct Frame {
    LAS unsigned char* lds; int tid, lane, wave, vcu, G;
};
typedef const __attribute__((address_space(4))) Args* KArgs;
__device__ __forceinline__ bf16_t* wl_base(KArgs a, int l) {
    return l < 2 ? (bf16_t*)(a->out + O_SDNS + (size_t)NB_S * NH * HD * HD) + (size_t)l * WL_SIZE : (bf16_t*)(a->ws + WS_W23) + (size_t)(l - 2) * WL_SIZE;
}
__device__ __forceinline__ float* vec_base(KArgs a, int l) { return (float*)(a->ws + WS_VEC) + (size_t)l * VEC_L; }

__device__ __forceinline__ void p0_transpose_item(const float* W, int K, int N, int ldn, const float* gk, bf16_t* WT, LAS float* scr, int item, int nblk, int lane) {
    const int kb = item / nblk, nb = item % nblk, k0 = 64 * kb, n0 = 32 * nb;
    const int n = n0 + (lane & 31);
#pragma unroll 8
    for (int i = 0; i < 32; ++i) { const int kk = 2 * i + (lane >> 5); float v = (n < N) ? W[(size_t)(k0 + kk) * ldn + n] : 0.f; if (gk) v *= gk[k0 + kk]; scr[kk * 33 + (lane & 31)] = v; }
    asm volatile("s_waitcnt lgkmcnt(0)" ::: "memory");
    const int c = lane & 7;
#pragma unroll
    for (int j = 0; j < 4; ++j) { const int nn = (lane >> 3) + 8 * j; const LAS float* s = scr + (8 * c) * 33 + nn;
        u32x4 o; o.x = pk2(s[0 * 33], s[1 * 33]); o.y = pk2(s[2 * 33], s[3 * 33]); o.z = pk2(s[4 * 33], s[5 * 33]); o.w = pk2(s[6 * 33], s[7 * 33]);
        *(u32x4*)(WT + (size_t)(n0 + nn) * K + k0 + 8 * c) = o; }
    asm volatile("s_waitcnt lgkmcnt(0)" ::: "memory");
}
__device__ __forceinline__ void p0_transpose(const Frame& F, const float* W, int K, int N, int Npad, const float* gk, bf16_t* WT) {
    LAS float* scr = (LAS float*)(F.lds + F.wave * 16384);
    const int gw = F.vcu * NWAVES + F.wave, NGW = F.G * NWAVES, nblk = Npad / 32, nitems = (K / 64) * nblk;
    for (int it = gw; it < nitems; it += NGW) p0_transpose_item(W, K, N, N, gk, WT, scr, it, nblk, F.lane);
}
__device__ __forceinline__ void p0_prologue(const Frame& F, KArgs a) {
    for (int l = 0; l < DEPTH; ++l) {
        bf16_t* wb = wl_base(a, l); const int j = l >> 1;
        if ((l & 1) == 0) { p0_transpose(F, a->in[8] + (size_t)j * D * AIN, D, AIN, 4352, nullptr, wb + WL_IN); p0_transpose(F, a->in[13] + (size_t)j * D * D, D, D, D, nullptr, wb + WL_OUT); }
        else { p0_transpose(F, a->in[14] + (size_t)j * D * 3 * D, D, 3 * D, 3 * D, nullptr, wb + WL_IN); p0_transpose(F, a->in[16] + (size_t)j * D * D, D, D, D, nullptr, wb + WL_OUT); }
        p0_transpose(F, a->in[17] + (size_t)l * D * DFF2, D, DFF2, DFF2, a->in[20] + l * D, wb + WL_UP);
        p0_transpose(F, a->in[19] + (size_t)l * DFF * D, DFF, D, D, nullptr, wb + WL_DOWN);
        p0_transpose(F, a->in[25] + (size_t)l * D * D, D, D, D, a->in[22] + l * D, wb + WL_G);
        p0_transpose(F, a->in[24] + (size_t)l * DPLE * D, DPLE, D, D, nullptr, wb + WL_P);
    }
    const int gt = F.vcu * NTHR + F.tid, NGT = F.G * NTHR;
    for (int it = gt; it < DEPTH * (DFF2 + D); it += NGT) {
        const int l = it / (DFF2 + D), n0 = it % (DFF2 + D); const bool up = n0 < DFF2; const int n = up ? n0 : n0 - DFF2, N = up ? DFF2 : D;
        const float* W = up ? a->in[17] + (size_t)l * D * DFF2 : a->in[25] + (size_t)l * D * D;
        const float* g = (up ? a->in[20] : a->in[22]) + l * D; const float* b = (up ? a->in[21] : a->in[23]) + l * D;
        float s1 = 0.f, s2 = 0.f;
        for (int k = 0; k < D; ++k) { const float w = W[(size_t)k * N + n]; s1 += bf2f(f2bf(g[k] * w)); s2 += b[k] * w; }
        float* vb = vec_base(a, l); if (up) { vb[n] = s1; vb[DFF2 + n] = s2; } else { vb[2 * DFF2 + n] = s1; vb[2 * DFF2 + D + n] = s2; }
    }
    bf16_t* X0 = (bf16_t*)(a->ws + WS_X0); bf16_t* PB = (bf16_t*)(a->ws + WS_PB);
    for (size_t i = gt; i < (size_t)M * D / 8; i += NGT) { const size_t e = i * 8; const float* src = e < (size_t)M_P * D ? a->in[0] + e : a->in[1] + (e - (size_t)M_P * D);
        const f32x4 v0 = *(const f32x4*)src, v1 = *(const f32x4*)(src + 4); u32x4 w; w.x = pk2(v0[0], v0[1]); w.y = pk2(v0[2], v0[3]); w.z = pk2(v1[0], v1[1]); w.w = pk2(v1[2], v1[3]); *(u32x4*)(X0 + e) = w; }
    for (size_t i = gt; i < (size_t)DEPTH * M * DPLE / 8; i += NGT) { const size_t e = i * 8; const size_t l = e / ((size_t)M * DPLE), r = e % ((size_t)M * DPLE);
        const float* src = r < (size_t)M_P * DPLE ? a->in[2] + l * (size_t)M_P * DPLE + r : a->in[3] + l * (size_t)M_S * DPLE + (r - (size_t)M_P * DPLE);
        const f32x4 v0 = *(const f32x4*)src, v1 = *(const f32x4*)(src + 4); u32x4 w; w.x = pk2(v0[0], v0[1]); w.y = pk2(v0[2], v0[3]); w.z = pk2(v1[0], v1[1]); w.w = pk2(v1[2], v1[3]); *(u32x4*)(PB + e) = w; }
}

__device__ __forceinline__ void dn_chunk_phase(const Frame& F, KArgs a, int j) {
    const bf16_t* proj = (const bf16_t*)(a->ws + WS_R1); const float* ba = (const float*)(a->ws + WS_BA);
    const float* cw = a->in[9] + (size_t)j * 4 * QKV;
    LAS float* Am = (LAS float*)(F.lds);
    LAS float* sc = (LAS float*)(F.lds + 17408);
    LAS unsigned char* kn = F.lds + 18432;
    LAS unsigned char* qn = F.lds + 35840;
    LAS float* vv = (LAS float*)(F.lds + 53248);
    LAS unsigned char* wb = F.lds + 86016;
    const int tid = F.tid, lane = F.lane, wave = F.wave;
    for (int cu = F.vcu; cu < N_CU; cu += F.G) {
        const int n = cu & 31, h = (cu >> 5) & 7, b = cu >> 8, rowbase = b * SEQ + n * 64;
        unsigned char* cub = a->ws + WS_R2 + (size_t)cu * CU_BYTES;
        if (wave == 0) {
            const int r = rowbase + lane;
            const float b1 = ba[(size_t)r * 16 + h], b2 = ba[(size_t)r * 16 + 8 + h] + a->in[11][j * 8 + h];
            const float sp = b2 > 20.f ? b2 : log1pf(expf(b2));
            float c = -expf(a->in[10][j * 8 + h]) * sp;
#pragma unroll
            for (int o = 1; o < 64; o <<= 1) { const float t = __shfl_up(c, o); if (lane >= o) c += t; }
            const float gl = __shfl(c, 63);
            sc[lane] = c; sc[64 + lane] = sigmoidf_(b1); sc[128 + lane] = __expf(c); sc[192 + lane] = __expf(gl - c);
            if (lane == 0) ((float*)(a->ws + WS_R2 + R2_DEC))[cu] = __expf(gl);
        }
        __syncthreads();
#pragma unroll 1
        for (int ps = 0; ps < 6; ++ps) {
            const int part = ps >> 1, tok = (ps & 1) * 32 + (tid >> 4), g8 = tid & 15, col = part * 1024 + h * HD + 8 * g8, t = n * 64 + tok, r = rowbase + tok;
            float y[8];
#pragma unroll
            for (int e = 0; e < 8; ++e) y[e] = 0.f;
#pragma unroll
            for (int jj = 0; jj < 4; ++jj) { const int d = 3 - jj; float u[8];
                if (t - d >= 0) unpack8(*(const u32x4*)(proj + (size_t)(r - d) * PROJW + col), u);
                else {
#pragma unroll
                    for (int e = 0; e < 8; ++e) u[e] = 0.f; }
                const f32x4 w0 = *(const f32x4*)(cw + (size_t)jj * QKV + col), w1 = *(const f32x4*)(cw + (size_t)jj * QKV + col + 4);
#pragma unroll
                for (int e = 0; e < 4; ++e) { y[e] += w0[e] * u[e]; y[4 + e] += w1[e] * u[4 + e]; }
                if (jj == 3 && t >= SEQ - 3) { float* o = a->out + O_PDNC + (((size_t)j * NB_P + b) * 3 + (t - (SEQ - 3))) * QKV + col;
                    *(f32x4*)o = (f32x4){u[0], u[1], u[2], u[3]}; *(f32x4*)(o + 4) = (f32x4){u[4], u[5], u[6], u[7]}; } }
            float ss = 0.f;
#pragma unroll
            for (int e = 0; e < 8; ++e) { y[e] = siluf_(y[e]); ss += y[e] * y[e]; }
            if (part < 2) {
                ss += __shfl_xor(ss, 1); ss += __shfl_xor(ss, 2); ss += __shfl_xor(ss, 4); ss += __shfl_xor(ss, 8);
                const float sl = rsqrtf(ss + L2_EPS) * (part == 0 ? QSCALE : 1.0f);
                u32x4 w; w.x = cvtpk(y[0] * sl, y[1] * sl); w.y = cvtpk(y[2] * sl, y[3] * sl); w.z = cvtpk(y[4] * sl, y[5] * sl); w.w = cvtpk(y[6] * sl, y[7] * sl);
                *(LAS u32x4*)((part == 0 ? qn : kn) + tok * 272 + g8 * 16) = w;
            } else {
                const float bt = sc[64 + tok];
                *(LAS f32x4*)(vv + tok * 128 + 8 * g8) = (f32x4){y[0] * bt, y[1] * bt, y[2] * bt, y[3] * bt}; *(LAS f32x4*)(vv + tok * 128 + 8 * g8 + 4) = (f32x4){y[4] * bt, y[5] * bt, y[6] * bt, y[7] * bt};
            }
        }
        __syncthreads();
        if (wave < 6) {
            const int kind = wave >= 3, pr = wave - 3 * kind, mj = pr == 2, mi = pr >= 1, r32 = lane & 31, hh = lane >> 5;
            f32x16 acc;
#pragma unroll
            for (int e = 0; e < 16; ++e) acc[e] = 0.f;
            const LAS unsigned char* ap = kn + (32 * mj + r32) * 272 + hh * 16; const LAS unsigned char* bp = (kind ? qn : kn) + (32 * mi + r32) * 272 + hh * 16;
#pragma unroll
            for (int s = 0; s < 8; ++s) acc = __builtin_amdgcn_mfma_f32_32x32x16_bf16(*(const LAS bf16x8*)(ap + 32 * s), *(const LAS bf16x8*)(bp + 32 * s), acc, 0, 0, 0);
            const int i = 32 * mi + r32; const float gci = sc[i], bi = sc[64 + i];
            if (kind == 0) {
#pragma unroll
                for (int q4 = 0; q4 < 4; ++q4) { const int j0 = 32 * mj + 8 * q4 + 4 * hh; f32x4 o;
#pragma unroll
                    for (int e = 0; e < 4; ++e) { const int jj = j0 + e; o[e] = (i > jj) ? bi * acc[4 * q4 + e] * __expf(fminf(gci - sc[jj], 0.f)) : 0.f; }
                    *(LAS f32x4*)(Am + i * 68 + j0) = o; }
            } else {
#pragma unroll
                for (int s = 0; s < 2; ++s) { float v[8];
#pragma unroll
                    for (int e = 0; e < 8; ++e) { const int jj = 32 * mj + crow(8 * s + e, hh); v[e] = (i >= jj) ? acc[8 * s + e] * __expf(fminf(gci - sc[jj], 0.f)) : 0.f; }
                    u32x4 w; w.x = cvtpk(v[0], v[1]); w.y = cvtpk(v[2], v[3]); w.z = cvtpk(v[4], v[5]); w.w = cvtpk(v[6], v[7]);
                    *(u32x4*)(cub + CU_AF + (pr * 2 + s) * 1024 + lane * 16) = w; }
            }
        }
        __syncthreads();
        if (wave < 4) {
            float X[64];
            if (wave < 2) {
#pragma unroll
                for (int i = 0; i < 64; ++i) X[i] = vv[i * 128 + 64 * wave + lane];
            } else {
#pragma unroll
                for (int i = 0; i < 64; ++i) X[i] = bf2f(*(const LAS unsigned short*)(kn + i * 272 + (64 * (wave - 2) + lane) * 2)) * (sc[64 + i] * sc[128 + i]);
            }
#pragma unroll
            for (int i = 1; i < 64; ++i) {
                float a0 = X[i], a1 = 0.f;
#pragma unroll
                for (int j4 = 0; j4 < i; j4 += 4) { const f32x4 av = *(const LAS f32x4*)(Am + i * 68 + j4);
                    a0 -= av[0] * X[j4]; if (j4 + 1 < i) a1 -= av[1] * X[j4 + 1]; if (j4 + 2 < i) a0 -= av[2] * X[j4 + 2]; if (j4 + 3 < i) a1 -= av[3] * X[j4 + 3]; }
                X[i] = a0 + a1;
            }
            if (wave < 2) { float* U = (float*)(cub + CU_U) + 64 * wave + lane;
#pragma unroll
                for (int i = 0; i < 64; ++i) U[i * 128] = X[i];
            } else {
#pragma unroll
                for (int i = 0; i < 64; ++i) *(LAS unsigned short*)(wb + i * 272 + (64 * (wave - 2) + lane) * 2) = (unsigned short)f2bf(X[i]);
            }
        } else {
            const int t2 = tid - 256;
#pragma unroll 1
            for (int k = 0; k < 4; ++k) { const int vi = t2 + 256 * k, f = vi >> 6, ln = vi & 63, r32 = ln & 31, hh = ln >> 5;
                { const int mtok = f >> 3, mt = (f >> 1) & 3, s = f & 1, tok = 32 * mtok + r32, kd0 = 32 * mt + 16 * s + 4 * hh; const float eg = sc[128 + tok];
                  const u32x2 lo = *(const LAS u32x2*)(qn + tok * 272 + kd0 * 2), hi = *(const LAS u32x2*)(qn + tok * 272 + (kd0 + 8) * 2);
                  u32x4 w; w.x = cvtpk(bf2f(lo.x & 0xffffu) * eg, bf2f(lo.x >> 16) * eg); w.y = cvtpk(bf2f(lo.y & 0xffffu) * eg, bf2f(lo.y >> 16) * eg);
                  w.z = cvtpk(bf2f(hi.x & 0xffffu) * eg, bf2f(hi.x >> 16) * eg); w.w = cvtpk(bf2f(hi.y & 0xffffu) * eg, bf2f(hi.y >> 16) * eg);
                  *(u32x4*)(cub + CU_QF + f * 1024 + ln * 16) = w; }
                { const int mt = f >> 2, mtok = (f >> 1) & 1, s = f & 1, kd = 32 * mt + r32; float v[8];
#pragma unroll
                  for (int e = 0; e < 8; ++e) { const int tk = 32 * mtok + 16 * s + 8 * (e >> 2) + 4 * hh + (e & 3); v[e] = bf2f(*(const LAS unsigned short*)(kn + tk * 272 + kd * 2)) * sc[192 + tk]; }
                  u32x4 w; w.x = cvtpk(v[0], v[1]); w.y = cvtpk(v[2], v[3]); w.z = cvtpk(v[4], v[5]); w.w = cvtpk(v[6], v[7]);
                  *(u32x4*)(cub + CU_KF + f * 1024 + ln * 16) = w; }
            }
        }
        __syncthreads();
#pragma unroll 1
        for (int k = 0; k < 2; ++k) { const int vi = tid + 512 * k, f = vi >> 6, ln = vi & 63, r32 = ln & 31, hh = ln >> 5;
            const int mtok = f >> 3, mt = (f >> 1) & 3, s = f & 1, tok = 32 * mtok + r32, kd0 = 32 * mt + 16 * s + 4 * hh;
            const u32x2 lo = *(const LAS u32x2*)(wb + tok * 272 + kd0 * 2), hi = *(const LAS u32x2*)(wb + tok * 272 + (kd0 + 8) * 2);
            *(u32x4*)(cub + CU_WF + f * 1024 + ln * 16) = (u32x4){lo.x, lo.y, hi.x, hi.y}; }
        __syncthreads();
    }
}

__device__ __forceinline__ void dn_scan_unit(const Frame& F, KArgs a, int j, int bh) {
    const int w = F.wave, lane = F.lane;
    const unsigned char* cub = a->ws + WS_R2 + (size_t)bh * 32 * CU_BYTES;
    if (w >= 4) {
        const int lw = w - 4;
        for (int n = 0; n <= 32; ++n) {
            if (n < 32) { const unsigned char* src = cub + (size_t)n * CU_BYTES + lane * 16; LAS unsigned char* dst = F.lds + (n & 1) * CU_LDS;
                for (int pc = lw; pc < 54; pc += 4) __builtin_amdgcn_global_load_lds((const unsigned*)(src + pc * 1024), (LAS unsigned*)(dst + pc * 1024), 16, 0, 0); }
            asm volatile("s_waitcnt vmcnt(0)" ::: "memory");
            __syncthreads();
        }
    } else {
        const int v = lane & 31, hh = lane >> 5, b = bh >> 3, h = bh & 7;
        f32x16 S[4];
#pragma unroll
        for (int mt = 0; mt < 4; ++mt)
#pragma unroll
            for (int e = 0; e < 16; ++e) S[mt][e] = 0.f;
        const float* decp = (const float*)(a->ws + WS_R2 + R2_DEC) + bh * 32;
        float* Og = (float*)(a->ws + WS_R1);
        __syncthreads();
        for (int n = 0; n < 32; ++n) {
            const LAS unsigned char* buf = F.lds + (n & 1) * CU_LDS + lane * 16;
            const float* U = (const float*)(cub + (size_t)n * CU_BYTES + CU_U) + 32 * w + v;
            f32x16 un[2];
#pragma unroll
            for (int mtok = 0; mtok < 2; ++mtok)
#pragma unroll
                for (int e = 0; e < 16; ++e) un[mtok][e] = U[(32 * mtok + crow(e, hh)) * 128];
            const float dec = decp[n];
            bf16x8 Sb[4][2];
#pragma unroll
            for (int mt = 0; mt < 4; ++mt)
#pragma unroll
                for (int s = 0; s < 2; ++s) { u32x4 p; p.x = cvtpk(S[mt][8 * s], S[mt][8 * s + 1]); p.y = cvtpk(S[mt][8 * s + 2], S[mt][8 * s + 3]); p.z = cvtpk(S[mt][8 * s + 4], S[mt][8 * s + 5]); p.w = cvtpk(S[mt][8 * s + 6], S[mt][8 * s + 7]);
                    Sb[mt][s] = __builtin_bit_cast(bf16x8, p); }
            f32x16 acc[2];
#pragma unroll
            for (int mtok = 0; mtok < 2; ++mtok) {
#pragma unroll
                for (int e = 0; e < 16; ++e) acc[mtok][e] = 0.f;
#pragma unroll
                for (int mt = 0; mt < 4; ++mt)
#pragma unroll
                    for (int s = 0; s < 2; ++s) acc[mtok] = __builtin_amdgcn_mfma_f32_32x32x16_bf16(*(const LAS bf16x8*)(buf + CU_WF + ((mtok * 4 + mt) * 2 + s) * 1024), Sb[mt][s], acc[mtok], 0, 0, 0);
            }
            bf16x8 vnb[2][2];
#pragma unroll
            for (int mtok = 0; mtok < 2; ++mtok) {
#pragma unroll
                for (int e = 0; e < 16; ++e) acc[mtok][e] = un[mtok][e] - acc[mtok][e];
#pragma unroll
                for (int s = 0; s < 2; ++s) { u32x4 p; p.x = cvtpk(acc[mtok][8 * s], acc[mtok][8 * s + 1]); p.y = cvtpk(acc[mtok][8 * s + 2], acc[mtok][8 * s + 3]); p.z = cvtpk(acc[mtok][8 * s + 4], acc[mtok][8 * s + 5]); p.w = cvtpk(acc[mtok][8 * s + 6], acc[mtok][8 * s + 7]);
                    vnb[mtok][s] = __builtin_bit_cast(bf16x8, p); }
            }
#pragma unroll
            for (int mtok = 0; mtok < 2; ++mtok) {
                f32x16 o;
#pragma unroll
                for (int e = 0; e < 16; ++e) o[e] = 0.f;
#pragma unroll
                for (int mt = 0; mt < 4; ++mt)
#pragma unroll
                    for (int s = 0; s < 2; ++s) o = __builtin_amdgcn_mfma_f32_32x32x16_bf16(*(const LAS bf16x8*)(buf + CU_QF + ((mtok * 4 + mt) * 2 + s) * 1024), Sb[mt][s], o, 0, 0, 0);
#pragma unroll
                for (int mp = 0; mp <= mtok; ++mp)
#pragma unroll
                    for (int s = 0; s < 2; ++s) o = __builtin_amdgcn_mfma_f32_32x32x16_bf16(*(const LAS bf16x8*)(buf + CU_AF + ((mtok + mp) * 2 + s) * 1024), vnb[mp][s], o, 0, 0, 0);
                float* op = Og + (size_t)(b * SEQ + n * 64 + 32 * mtok) * OLD + h * HD + 32 * w + v;
#pragma unroll
                for (int e = 0; e < 16; ++e) op[(size_t)crow(e, hh) * OLD] = o[e];
            }
#pragma unroll
            for (int mt = 0; mt < 4; ++mt) {
#pragma unroll
                for (int e = 0; e < 16; ++e) S[mt][e] *= dec;
#pragma unroll
                for (int mtok = 0; mtok < 2; ++mtok)
#pragma unroll
                    for (int s = 0; s < 2; ++s) S[mt] = __builtin_amdgcn_mfma_f32_32x32x16_bf16(*(const LAS bf16x8*)(buf + CU_KF + ((mt * 2 + mtok) * 2 + s) * 1024), vnb[mtok][s], S[mt], 0, 0, 0);
            }
            __syncthreads();
        }
        float* so = a->out + O_PDNS + ((size_t)j * NB_P * NH + bh) * HD * HD + 32 * w + v;
#pragma unroll
        for (int mt = 0; mt < 4; ++mt)
#pragma unroll
            for (int e = 0; e < 16; ++e) so[(size_t)(32 * mt + crow(e, hh)) * HD] = S[mt][e];
    }
}

__device__ __forceinline__ void dn_sample_unit(const Frame& F, KArgs a, int j, int u) {
    const int tid = F.tid, b = u >> 3, h = u & 7, row0 = M_P + b * DSEQ;
    const bf16_t* proj = (const bf16_t*)(a->ws + WS_R1); const float* ba = (const float*)(a->ws + WS_BA);
    const float* cw = a->in[9] + (size_t)j * 4 * QKV; const float* sbuf = a->in[4] + ((size_t)j * NB_S + b) * 3 * QKV;
    LAS float* qn = (LAS float*)F.lds;
    LAS float* kn = qn + 1024;
    LAS float* vb = kn + 1024;
    LAS float* ul = vb + 1024;
    LAS float* wl = ul + 1024;
    LAS float* vn = wl + 1024;
    LAS float* A8 = vn + 1024;
    LAS float* T8 = A8 + 64;
    LAS float* sc = T8 + 64;
    LAS float* red = sc + 64;
    __syncthreads();
    if (tid < 8) {
        const int r = row0 + tid;
        const float b1 = ba[(size_t)r * 16 + h], b2 = ba[(size_t)r * 16 + 8 + h] + a->in[11][j * 8 + h];
        const float sp = b2 > 20.f ? b2 : log1pf(expf(b2));
        float c = -expf(a->in[10][j * 8 + h]) * sp;
#pragma unroll
        for (int o = 1; o < 8; o <<= 1) { const float t = __shfl_up(c, o); if (tid >= o) c += t; }
        const float gl = __shfl(c, 7);
        sc[tid] = c; sc[8 + tid] = sigmoidf_(b1); sc[16 + tid] = __expf(c); sc[24 + tid] = __expf(gl - c); if (tid == 0) sc[32] = __expf(gl);
    }
    __syncthreads();
    if (tid < 384) {
        const int rr = tid >> 4, part = rr >> 3, tok = rr & 7, g8 = tid & 15, col = part * 1024 + h * HD + 8 * g8, r = row0 + tok;
        float y[8];
#pragma unroll
        for (int e = 0; e < 8; ++e) y[e] = 0.f;
#pragma unroll
        for (int jj = 0; jj < 4; ++jj) { const int d = 3 - jj; float uu[8];
            if (tok - d >= 0) unpack8(*(const u32x4*)(proj + (size_t)(r - d) * PROJW + col), uu);
            else { const float* p = sbuf + (size_t)(tok + jj) * QKV + col;
#pragma unroll
                for (int e = 0; e < 8; ++e) uu[e] = p[e]; }
            const f32x4 w0 = *(const f32x4*)(cw + (size_t)jj * QKV + col), w1 = *(const f32x4*)(cw + (size_t)jj * QKV + col + 4);
#pragma unroll
            for (int e = 0; e < 4; ++e) { y[e] += w0[e] * uu[e]; y[4 + e] += w1[e] * uu[4 + e]; }
            if (jj == 3 && tok >= DSEQ - 3) { float* o = a->out + O_SDNC + (((size_t)j * NB_S + b) * 3 + (tok - (DSEQ - 3))) * QKV + col;
                *(f32x4*)o = (f32x4){uu[0], uu[1], uu[2], uu[3]}; *(f32x4*)(o + 4) = (f32x4){uu[4], uu[5], uu[6], uu[7]}; } }
        float ss = 0.f;
#pragma unroll
        for (int e = 0; e < 8; ++e) { y[e] = siluf_(y[e]); ss += y[e] * y[e]; }
        ss += __shfl_xor(ss, 1); ss += __shfl_xor(ss, 2); ss += __shfl_xor(ss, 4); ss += __shfl_xor(ss, 8);
        const float sl = part == 0 ? rsqrtf(ss + L2_EPS) * QSCALE : (part == 1 ? rsqrtf(ss + L2_EPS) : sc[8 + tok]);
        LAS float* dst = (part == 0 ? qn : (part == 1 ? kn : vb)) + tok * 128 + 8 * g8;
        *(LAS f32x4*)dst = (f32x4){y[0] * sl, y[1] * sl, y[2] * sl, y[3] * sl}; *(LAS f32x4*)(dst + 4) = (f32x4){y[4] * sl, y[5] * sl, y[6] * sl, y[7] * sl};
    }
    __syncthreads();
    {
        const int d = tid >> 3, i = d >> 3, jx = d & 7, sub = tid & 7; float kk = 0.f, qk = 0.f;
#pragma unroll
        for (int e = 0; e < 16; ++e) { const float kj = kn[jx * 128 + 16 * sub + e]; kk += kn[i * 128 + 16 * sub + e] * kj; qk += qn[i * 128 + 16 * sub + e] * kj; }
        kk += __shfl_xor(kk, 1); kk += __shfl_xor(kk, 2); kk += __shfl_xor(kk, 4); qk += __shfl_xor(qk, 1); qk += __shfl_xor(qk, 2); qk += __shfl_xor(qk, 4);
        if (sub == 0) { const float dc = __expf(fminf(sc[i] - sc[jx], 0.f)); A8[d] = i > jx ? sc[8 + i] * kk * dc : 0.f; T8[d] = i >= jx ? qk * dc : 0.f; }
    }
    __syncthreads();
    if (tid < 256) {
        const int c = tid & 127, isw = tid >> 7; float X[8];
#pragma unroll
        for (int i = 0; i < 8; ++i) X[i] = isw ? kn[i * 128 + c] * sc[8 + i] * sc[16 + i] : vb[i * 128 + c];
#pragma unroll
        for (int i = 1; i < 8; ++i)
#pragma unroll
            for (int jx = 0; jx < i; ++jx) X[i] -= A8[i * 8 + jx] * X[jx];
        LAS float* dst = isw ? wl : ul;
#pragma unroll
        for (int i = 0; i < 8; ++i) dst[i * 128 + c] = X[i];
    }
    __syncthreads();
    const int v = tid & 127, kq = tid >> 7;
    float S[32];
    { const float* s0 = a->in[5] + (((size_t)j * NB_S + b) * NH + h) * HD * HD + (size_t)(32 * kq) * HD + v;
#pragma unroll
      for (int i = 0; i < 32; ++i) S[i] = s0[(size_t)i * HD]; }
#pragma unroll
    for (int c = 0; c < 8; ++c) { float pw = 0.f, pq = 0.f;
#pragma unroll
        for (int i4 = 0; i4 < 32; i4 += 4) { const f32x4 wv = *(const LAS f32x4*)(wl + c * 128 + 32 * kq + i4), qv = *(const LAS f32x4*)(qn + c * 128 + 32 * kq + i4);
#pragma unroll
            for (int e = 0; e < 4; ++e) { pw += wv[e] * S[i4 + e]; pq += qv[e] * S[i4 + e]; } }
        red[((0 * 4 + kq) * 8 + c) * 128 + v] = pw; red[((1 * 4 + kq) * 8 + c) * 128 + v] = pq * sc[16 + c]; }
    __syncthreads();
    float vnew[8];
#pragma unroll
    for (int c = 0; c < 8; ++c) vnew[c] = ul[c * 128 + v] - ((red[((0 * 4 + 0) * 8 + c) * 128 + v] + red[((0 * 4 + 1) * 8 + c) * 128 + v]) + (red[((0 * 4 + 2) * 8 + c) * 128 + v] + red[((0 * 4 + 3) * 8 + c) * 128 + v]));
    { const float dec = sc[32];
#pragma unroll
      for (int i = 0; i < 32; ++i) S[i] *= dec; }
#pragma unroll
    for (int c = 0; c < 8; ++c) { const float vc = vnew[c] * sc[24 + c];
#pragma unroll
        for (int i4 = 0; i4 < 32; i4 += 4) { const f32x4 kv = *(const LAS f32x4*)(kn + c * 128 + 32 * kq + i4);
#pragma unroll
            for (int e = 0; e < 4; ++e) S[i4 + e] += kv[e] * vc; } }
    { float* so = a->out + O_SDNS + (((size_t)j * NB_S + b) * NH + h) * HD * HD + (size_t)(32 * kq) * HD + v;
#pragma unroll
      for (int i = 0; i < 32; ++i) so[(size_t)i * HD] = S[i]; }
    {
        float* Og = (float*)(a->ws + WS_R2 + R2_OS);
#pragma unroll
        for (int cc = 0; cc < 2; ++cc) { const int c = 2 * kq + cc;
            float o = (red[((1 * 4 + 0) * 8 + c) * 128 + v] + red[((1 * 4 + 1) * 8 + c) * 128 + v]) + (red[((1 * 4 + 2) * 8 + c) * 128 + v] + red[((1 * 4 + 3) * 8 + c) * 128 + v]);
#pragma unroll
            for (int jx = 0; jx < 8; ++jx) o += T8[c * 8 + jx] * vnew[jx];
            Og[(size_t)(b * DSEQ + c) * D + h * HD + v] = o; }
    }
}
__device__ __forceinline__ void dn_scan_phase(const Frame& F, KArgs a, int j) {
    if ((F.vcu & 3) == 0) dn_scan_unit(F, a, j, F.vcu >> 2);
    else { const int idx = F.vcu - (F.vcu >> 2) - 1, nw = F.G - (F.G >> 2); for (int u = idx; u < NB_S * NH; u += nw) dn_sample_unit(F, a, j, u); }
}
__device__ __forceinline__ void dn_gate_phase(const Frame& F, KArgs a, int j) {
    bf16_t* proj = (bf16_t*)(a->ws + WS_R1); const float* O = (const float*)(a->ws + WS_R1); const float* ng = a->in[12] + j * HD;
    const int gw = F.vcu * NWAVES + F.wave, NGW = F.G * NWAVES, lane = F.lane;
    const f32x2 nv = *(const f32x2*)(ng + 2 * lane);
    for (int it = gw; it < M * NH; it += NGW) {
        const int r = it >> 3, h = it & 7;
        const f32x2 o = *(const f32x2*)((r < M_P ? O + (size_t)r * OLD : (const float*)(a->ws + WS_R2 + R2_OS) + (size_t)(r - M_P) * D) + h * HD + 2 * lane);
        const float rs = rsqrtf(wave_sum(o.x * o.x + o.y * o.y) * (1.0f / HD) + RMS_EPS);
        bf16_t* zp = proj + (size_t)r * PROJW + QKV + h * HD + 2 * lane; const unsigned zw = *(const unsigned*)zp;
        *(unsigned*)zp = pk2(o.x * rs * nv.x * siluf_(bf2f(zw & 0xffffu)), o.y * rs * nv.y * siluf_(bf2f(zw >> 16)));
    }
}
__device__ __forceinline__ void sc_act_phase(const Frame& F, KArgs a, int j) {
    bf16_t* proj = (bf16_t*)(a->ws + WS_R1); const float* cw = a->in[15] + (size_t)j * 3 * D; const float* sbuf = a->in[6] + (size_t)j * NB_S * 2 * D;
    const int gw = F.vcu * NWAVES + F.wave, NGW = F.G * NWAVES, lane = F.lane;
    for (int it = gw; it < M * 2; it += NGW) {
        const int r = it >> 1, c0 = (it & 1) * 512 + 8 * lane; int b, t, L; bool smp; row_info(r, b, t, L, smp);
        float y[8];
#pragma unroll
        for (int e = 0; e < 8; ++e) y[e] = 0.f;
#pragma unroll
        for (int jj = 0; jj < 3; ++jj) { const int d = 2 - jj; float u[8];
            if (t - d >= 0) { float cc[8], hh[8]; unpack8(*(const u32x4*)(proj + (size_t)(r - d) * 3072 + 1024 + c0), cc); unpack8(*(const u32x4*)(proj + (size_t)(r - d) * 3072 + 2048 + c0), hh);
#pragma unroll
                for (int e = 0; e < 8; ++e) u[e] = cc[e] * hh[e]; }
            else if (smp) { const float* p = sbuf + ((size_t)b * 2 + (t + jj)) * D + c0;
#pragma unroll
                for (int e = 0; e < 8; ++e) u[e] = p[e]; }
            else {
#pragma unroll
                for (int e = 0; e < 8; ++e) u[e] = 0.f; }
            const float* wp = cw + (size_t)jj * D + c0;
#pragma unroll
            for (int e = 0; e < 8; ++e) y[e] += wp[e] * u[e];
            if (jj == 2 && t >= L - 2) { float* o = a->out + (smp ? O_SSC : O_PSC) + (((size_t)j * (smp ? NB_S : NB_P) + b) * 2 + (t - (L - 2))) * D + c0;
#pragma unroll
                for (int e = 0; e < 8; ++e) o[e] = u[e]; } }
        float bb[8]; bf16_t* bp = proj + (size_t)r * 3072 + c0; unpack8(*(const u32x4*)bp, bb);
#pragma unroll
        for (int e = 0; e < 8; ++e) y[e] *= bb[e];
        *(u32x4*)bp = pack8(y);
    }
}
__device__ __forceinline__ void ffn_act_phase(const Frame& F, KArgs a, int l) {
    const bf16_t* up = (const bf16_t*)(a->ws + WS_R2); bf16_t* act = (bf16_t*)(a->ws + WS_R1);
    const float* cw = a->in[18] + (size_t)l * 3 * DFF2; const float* sbuf = a->in[7] + (size_t)l * NB_S * 2 * DFF2;
    const int gw = F.vcu * NWAVES + F.wave, NGW = F.G * NWAVES, lane = F.lane;
    for (int it = gw; it < M * 6; it += NGW) {
        const int r = it / 6, c0 = (it % 6) * 512 + 8 * lane; if (c0 >= DFF) continue;
        int b, t, L; bool smp; row_info(r, b, t, L, smp);
        float yv[8], yg[8];
#pragma unroll
        for (int e = 0; e < 8; ++e) { yv[e] = 0.f; yg[e] = 0.f; }
#pragma unroll
        for (int jj = 0; jj < 3; ++jj) { const int d = 2 - jj; float uv[8], ug[8];
            if (t - d >= 0) { unpack8(*(const u32x4*)(up + (size_t)(r - d) * DFF2 + c0), uv); unpack8(*(const u32x4*)(up + (size_t)(r - d) * DFF2 + DFF + c0), ug); }
            else if (smp) { const float* p = sbuf + ((size_t)b * 2 + (t + jj)) * DFF2 + c0;
#pragma unroll
                for (int e = 0; e < 8; ++e) { uv[e] = p[e]; ug[e] = p[DFF + e]; } }
            else {
#pragma unroll
                for (int e = 0; e < 8; ++e) { uv[e] = 0.f; ug[e] = 0.f; } }
            const float* wp = cw + (size_t)jj * DFF2 + c0;
#pragma unroll
            for (int e = 0; e < 8; ++e) { yv[e] += wp[e] * uv[e]; yg[e] += wp[DFF + e] * ug[e]; }
            if (jj == 2 && t >= L - 2) { float* o = a->out + (smp ? O_SFFN : O_PFFN) + (((size_t)l * (smp ? NB_S : NB_P) + b) * 2 + (t - (L - 2))) * DFF2 + c0;
#pragma unroll
                for (int e = 0; e < 8; ++e) { o[e] = uv[e]; o[DFF + e] = ug[e]; } } }
#pragma unroll
        for (int e = 0; e < 8; ++e) yv[e] *= siluf_(yg[e]);
        *(u32x4*)(act + (size_t)r * DFF + c0) = pack8(yv);
    }
}

enum Kind { K_P0 = 0, K_PROJ, K_DN_PRE, K_DN_SCAN, K_DN_GATE, K_SC_ACT, K_WOUT, K_UP, K_ACT, K_DOWN, K_GATE };
constexpr int N_PHASES = 1 + 9 + 7 + 9 + 7;
__host__ __device__ __forceinline__ void decode_phase(int p, int& l, int& kind) {
    if (p == 0) { l = 0; kind = K_P0; return; }
    p -= 1; l = 0;
    for (;;) { const int n = (l & 1) ? 7 : 9; if (p < n) break; p -= n; ++l; }
    const unsigned long long dnk = 0xA98764321ull  , sck = 0xA987651ull  ;
    kind = (int)((((l & 1) == 0 ? dnk : sck) >> (4 * p)) & 0xFull);
}

__global__ void __launch_bounds__(NTHR, 2) mk_fwd(Args args) {
    extern __shared__ __attribute__((aligned(16))) unsigned char lds_raw[];
    Frame F; F.lds = (LAS unsigned char*)lds_raw; F.tid = threadIdx.x; F.lane = F.tid & 63; F.wave = __builtin_amdgcn_readfirstlane(F.tid >> 6);
    F.G = gridDim.x; { const int bx = blockIdx.x; F.vcu = (F.G % 8 == 0) ? (bx % 8) * (F.G / 8) + bx / 8 : bx; }
    volatile LAS unsigned* MISC = (volatile LAS unsigned*)(F.lds + MISC_OFF);
    for (int u = F.tid; u < (LDS_BYTES - LDSCTL_OFF) / 4; u += NTHR) ((LAS unsigned*)(F.lds + LDSCTL_OFF))[u] = 0u;
    __syncthreads();
    const int ph_lo = args.ph_lo, ph_hi = args.ph_hi;
    XcdBarrier bar; bar.bar = (unsigned*)(args.ws + WS_CTL) + CW_BAR; bar.x = 0; bar.st = nullptr;
    if (ph_hi - ph_lo > 1) bar = xcd_barrier_post((unsigned*)(args.ws + WS_CTL) + CW_BAR, MISC + 8);
    for (int p = ph_lo; p < ph_hi; ++p) {
        KArgs ka = (KArgs)__builtin_amdgcn_kernarg_segment_ptr(); asm volatile("" : "+s"(ka));
        { int t_ = threadIdx.x; asm volatile("" : "+v"(t_)); F.tid = t_; F.lane = t_ & 63; F.wave = __builtin_amdgcn_readfirstlane(t_ >> 6); }
        int l, kind; decode_phase(p, l, kind);
        const int j = l >> 1; const bool dn = (l & 1) == 0;
        unsigned char* ws = ka->ws;
        switch (kind) {
        case K_P0: p0_prologue(F, ka); break;
        case K_PROJ: {
            const int N = dn ? 4352 : 3072;
            pg8::Gemm g{(const bf16_t*)(ws + ((l & 1) ? WS_X1 : WS_X0)), wl_base(ka, l) + WL_IN, M, N, D, D}; pg8::StaticOrder S; S.init(M, N, F.G, (int)blockIdx.x);
            pg8::EpiBf16 E{(bf16_t*)(ws + WS_R1), dn ? PROJW : 3072, (float*)(ws + WS_BA), dn ? 16 : -1};
            pg8::gemm_phase<pg8::EpiBf16, pg8::StaticOrder>(F.lds, F.tid, g, S, E);
        } break;
        case K_DN_PRE: dn_chunk_phase(F, ka, j); break;
        case K_DN_SCAN: dn_scan_phase(F, ka, j); break;
        case K_DN_GATE: dn_gate_phase(F, ka, j); break;
        case K_SC_ACT: sc_act_phase(F, ka, j); break;
        case K_WOUT: {
            const bf16_t* R1 = (const bf16_t*)(ws + WS_R1);
            pg8::Gemm g{dn ? R1 + QKV : R1, wl_base(ka, l) + WL_OUT, M, D, D, dn ? PROJW : 3072}; pg8::StaticOrder S; S.init(M, D, F.G, (int)blockIdx.x);
            pg8::EpiResStats E{(bf16_t*)(ws + ((l & 1) ? WS_X1 : WS_X0)), (float*)(ws + WS_ST1)};
            pg8::gemm_phase<pg8::EpiResStats, pg8::StaticOrder>(F.lds, F.tid, g, S, E);
        } break;
        case K_UP: {
            const float* vb = vec_base(ka, l);
            pg8::Gemm g{(const bf16_t*)(ws + ((l & 1) ? WS_X1 : WS_X0)), wl_base(ka, l) + WL_UP, M, DFF2, D, D}; pg8::StaticOrder S; S.init(M, DFF2, F.G, (int)blockIdx.x);
            pg8::EpiLnFold E{(bf16_t*)(ws + WS_R2), DFF2, (const float*)(ws + WS_ST1), vb, vb + DFF2};
            pg8::gemm_phase<pg8::EpiLnFold, pg8::StaticOrder>(F.lds, F.tid, g, S, E);
        } break;
        case K_ACT: {
            ffn_act_phase(F, ka, l);
            pg8::Gemm g{(const bf16_t*)(ws + WS_PB) + (size_t)l * M * DPLE, wl_base(ka, l) + WL_P, M, D, DPLE, DPLE}; pg8::StaticOrder S; S.init(M, D, F.G, (int)blockIdx.x);
            pg8::EpiBf16 E{(bf16_t*)(ws + WS_R1) + (size_t)M * DFF, D, nullptr, -1};
            pg8::gemm_phase<pg8::EpiBf16, pg8::StaticOrder>(F.lds, F.tid, g, S, E);
        } break;
        case K_DOWN: {
            pg8::Gemm g{(const bf16_t*)(ws + WS_R1), wl_base(ka, l) + WL_DOWN, M, D, DFF, DFF}; pg8::StaticOrder S; S.init(M, D, F.G, (int)blockIdx.x);
            pg8::EpiLnResStats E{(bf16_t*)(ws + ((l & 1) ? WS_X1 : WS_X0)), (const float*)(ws + WS_ST1), (float*)(ws + WS_ST2), ka->in[20] + l * D, ka->in[21] + l * D};
            pg8::gemm_phase<pg8::EpiLnResStats, pg8::StaticOrder>(F.lds, F.tid, g, S, E);
        } break;
        case K_GATE: {
            const float* vb = vec_base(ka, l);
            const bf16_t* Xc = (const bf16_t*)(ws + ((l & 1) ? WS_X1 : WS_X0));
            pg8::Gemm g{Xc, wl_base(ka, l) + WL_G, M, D, D, D}; pg8::StaticOrder S; S.init(M, D, F.G, (int)blockIdx.x);
            pg8::EpiGate E{Xc, (const bf16_t*)(ws + WS_R1) + (size_t)M * DFF, (bf16_t*)(ws + ((l & 1) ? WS_X0 : WS_X1)), l == DEPTH - 1 ? ka->out + O_Y : nullptr, (const float*)(ws + WS_ST2),
                           vb + 2 * DFF2, vb + 2 * DFF2 + D, ka->in[22] + l * D, ka->in[23] + l * D};
            pg8::gemm_phase<pg8::EpiGate, pg8::StaticOrder>(F.lds, F.tid, g, S, E);
        } break;
        default: break;
        }
        if (p + 1 < ph_hi) xcd_barrier(bar);
    }
}

extern "C" void kernel_launch(void* const* d_in, const int* in_sizes, int n_in, void* d_out, int out_size, void* d_ws, size_t ws_size, hipStream_t stream) {
    static int grid = 0;
    if (grid == 0) {
        if (n_in != 26 || out_size != (int)O_END || ws_size < WS_END) { fprintf(stderr, "kernel_launch: unexpected shapes (n_in %d, out %d, ws %zu; need ws >= %zu)\n", n_in, out_size, ws_size, (size_t)WS_END); grid = -1; return; }
        int dev = 0, cus = 0;
        if (hipGetDevice(&dev) != hipSuccess || hipDeviceGetAttribute(&cus, hipDeviceAttributeMultiprocessorCount, dev) != hipSuccess) { grid = -1; return; }
        if (hipFuncSetAttribute((const void*)mk_fwd, hipFuncAttributeMaxDynamicSharedMemorySize, LDS_BYTES) != hipSuccess) { fprintf(stderr, "kernel_launch: hipFuncSetAttribute failed\n"); grid = -1; return; }
        int per_cu = 0; (void)hipOccupancyMaxActiveBlocksPerMultiprocessor(&per_cu, (const void*)mk_fwd, NTHR, LDS_BYTES); (void)hipGetLastError();
        grid = cus;
    }
    if (grid < 0) return;
    (void)hipMemsetAsync((char*)d_ws + WS_CTL, 0, CTL_ZERO_BYTES, stream);
    Args a{};
    for (int i = 0; i < 26; ++i) a.in[i] = (const float*)d_in[i];
    a.out = (float*)d_out; a.ws = (unsigned char*)d_ws;
#if MK_PER_PHASE_LAUNCH
    for (int p = 0; p < N_PHASES; ++p) { a.ph_lo = p; a.ph_hi = p + 1; hipLaunchKernelGGL(mk_fwd, dim3(grid), dim3(NTHR), LDS_BYTES, stream, a); }
#else
    a.ph_lo = 0; a.ph_hi = N_PHASES; hipLaunchKernelGGL(mk_fwd, dim3(grid), dim3(NTHR), LDS_BYTES, stream, a);
#endif
}
```

```cpp
#include <hip/hip_runtime.h>
#include <cstdio>
#include <cstdint>

#ifndef MK_PER_PHASE_LAUNCH
#define MK_PER_PHASE_LAUNCH 0
#endif

#ifndef MK_SUB_REP
#define MK_SUB_REP 1
#endif
#ifndef MK_CONV_REP
#define MK_CONV_REP 1
#endif
#ifndef MK_DOUBLE_MASK
#define MK_DOUBLE_MASK 0
#endif
#define LAS __attribute__((address_space(3)))
#define GAS __attribute__((address_space(1)))
typedef unsigned short bf16_t;
typedef short bf16x8 __attribute__((ext_vector_type(8)));
typedef float f32x4 __attribute__((ext_vector_type(4)));
typedef float f32x2 __attribute__((ext_vector_type(2)));
typedef unsigned u32x4 __attribute__((ext_vector_type(4)));
typedef unsigned u32x2 __attribute__((ext_vector_type(2)));

constexpr int D = 1024, M_P = 16384, M_S = 1024, M = M_P + M_S, SEQ = 2048, DSEQ = 8, NB_P = 8, NB_S = 128;
constexpr int NH = 8, HD = 128, QKV = 3072, AIN = 4112, PROJW = 4096, DFF = 2816, DFF2 = 5632, DPLE = 256, DEPTH = 4;
constexpr float ALPHA = 1.6817928305074290f;
constexpr float LN_EPS = 1e-5f, RMS_EPS = 1e-6f, L2_EPS = 1e-6f;
constexpr float QSCALE = 0.08838834764831845f;

constexpr size_t O_Y = 0, O_PDNC = 17825792, O_PDNS = O_PDNC + 147456, O_PSC = O_PDNS + 2097152, O_PFFN = O_PSC + 32768,
                 O_SDNC = O_PFFN + 360448, O_SDNS = O_SDNC + 2359296, O_SSC = O_SDNS + 33554432, O_SFFN = O_SSC + 524288, O_END = O_SFFN + 5767168;

constexpr size_t WL_IN = 0, WL_OUT = WL_IN + (size_t)4352 * 1024, WL_UP = WL_OUT + (size_t)1024 * 1024, WL_DOWN = WL_UP + (size_t)DFF2 * 1024,
                 WL_G = WL_DOWN + (size_t)1024 * DFF, WL_P = WL_G + (size_t)1024 * 1024, WL_SIZE = WL_P + (size_t)1024 * 256;
constexpr size_t MiB = 1u << 20;
constexpr size_t WS_CTL = 0, CTL_ZERO_BYTES = 1 * MiB;
constexpr size_t WS_VEC = 1 * MiB;
constexpr size_t VEC_L = 2 * DFF2 + 2 * 1024;
constexpr size_t WS_BA = 2 * MiB;
constexpr size_t WS_GATES = WS_BA + (size_t)M * 16 * 4 + 65536;
constexpr size_t WS_ST1 = 5 * MiB, WS_ST2 = 8 * MiB;
constexpr size_t WS_W23 = 11 * MiB;
constexpr size_t WS_X0 = WS_W23 + 2 * WL_SIZE * 2;
constexpr size_t WS_X1 = WS_X0 + (size_t)M * D * 2;
constexpr size_t WS_PB = WS_X1 + (size_t)M * D * 2;
constexpr size_t WS_R1 = WS_PB + (size_t)4 * M * DPLE * 2;
constexpr size_t WS_R2 = WS_R1 + (size_t)M * PROJW * 2;
constexpr size_t WS_END = WS_R2 + (size_t)M * DFF2 * 2;
static_assert(WS_END <= (size_t)520 * MiB, "workspace budget");
constexpr int CU_WF = 0, CU_QF = 16384, CU_KF = 32768, CU_AF = 49152, CU_U = 55296, CU_BYTES = 88064, CU_LDS = 55296, N_CU = NB_P * NH * 32;
constexpr size_t R2_DEC = (size_t)N_CU * CU_BYTES;
static_assert(R2_DEC + N_CU * 4 <= (size_t)M * DFF2 * 2, "chunk intermediates fit in R2");
constexpr int OLD = 2048;
constexpr size_t R2_OS = R2_DEC + 65536;
static_assert(R2_OS + (size_t)M_S * D * 4 <= (size_t)M * DFF2 * 2, "sample o fits in R2");

__device__ __forceinline__ float bf2f(unsigned b) { return __uint_as_float(b << 16); }
__device__ __forceinline__ unsigned f2bf(float f) { unsigned u = __float_as_uint(f); return (u + 0x7fffu + ((u >> 16) & 1u)) >> 16; }
__device__ __forceinline__ unsigned pk2(float lo, float hi) { return f2bf(lo) | (f2bf(hi) << 16); }
typedef __bf16 bf16x2_t __attribute__((ext_vector_type(2)));
__device__ __forceinline__ unsigned cvtpk(float lo, float hi) { f32x2 v = {lo, hi}; bf16x2_t b = __builtin_convertvector(v, bf16x2_t); return __builtin_bit_cast(unsigned, b); }
__device__ __forceinline__ int crow(int reg, int hh) { return (reg & 3) + 8 * (reg >> 2) + 4 * hh; }
typedef float f32x16 __attribute__((ext_vector_type(16)));
__device__ __forceinline__ float sigmoidf_(float x) { return __builtin_amdgcn_rcpf(1.0f + __expf(-x)); }
__device__ __forceinline__ float siluf_(float x) { return x * __builtin_amdgcn_rcpf(1.0f + __expf(-x)); }
__device__ __forceinline__ void unpack8(const u32x4 w, float (&f)[8]) {
    f[0] = __uint_as_float(w.x << 16); f[1] = __uint_as_float(w.x & 0xffff0000u); f[2] = __uint_as_float(w.y << 16); f[3] = __uint_as_float(w.y & 0xffff0000u);
    f[4] = __uint_as_float(w.z << 16); f[5] = __uint_as_float(w.z & 0xffff0000u); f[6] = __uint_as_float(w.w << 16); f[7] = __uint_as_float(w.w & 0xffff0000u);
}
__device__ __forceinline__ u32x4 pack8(const float (&f)[8]) { u32x4 w; w.x = pk2(f[0], f[1]); w.y = pk2(f[2], f[3]); w.z = pk2(f[4], f[5]); w.w = pk2(f[6], f[7]); return w; }
__device__ __forceinline__ float wave_sum(float v) {
#pragma unroll
    for (int o = 1; o < 64; o <<= 1) v += __shfl_xor(v, o);
    return v;
}
__device__ __forceinline__ void row_info(int r, int& b, int& t, int& L, bool& smp) {
    if (r < M_P) { b = r >> 11; t = r & 2047; L = SEQ; smp = false; } else { const int q = r - M_P; b = q >> 3; t = q & 7; L = DSEQ; smp = true; }
}

namespace pg8 {
constexpr int BM = 256, BK = 64, HALF = 128, HTB = HALF * BK * 2, STAGE_BYTES = 8 * HTB, NXCD = 8, WGM = 8;
__host__ __device__ __forceinline__ int lds_byte(int r, int c) { const int st = (r >> 4) * 2 + (c >> 5), rr = r & 15, cc = c & 31, ob = rr * 64 + cc * 2; return st * 1024 + (ob ^ (((ob >> 9) & 1) << 5)); }
__host__ __device__ __forceinline__ void stage_rc(int b, int& R, int& C) { const int st = b / 1024, sb = b % 1024, swz = sb ^ (((sb >> 9) & 1) << 5); R = (st >> 1) * 16 + swz / 64; C = (st & 1) * 32 + (swz % 64) / 2; }
__host__ __device__ __forceinline__ int perm32(int rho) { const int n = rho >> 4, i = rho & 15; return 8 * (i >> 2) + 4 * n + (i & 3); }

struct Unit { int pm, pn; };
struct Gemm { const bf16_t* A; const bf16_t* Bt; int M, N, K, lda; };

struct StaticOrder {
    int nM, nN, nwg, G, c;
    __host__ __device__ void init(int M_, int N_, int G_, int c_) { nM = M_ / BM; nN = N_ / BM; nwg = nM * nN; G = G_; c = c_; }
    __host__ __device__ bool next(int i, Unit& u) const {
        const long L = (long)i * G + c; if (L >= nwg) return false;
        int wgid = (int)L; { const int q = nwg / NXCD, r = nwg % NXCD, xcd = wgid % NXCD, off = wgid / NXCD; wgid = (xcd < r ? xcd * (q + 1) : r * (q + 1) + (xcd - r) * q) + off; }
        const int nig = WGM * nN, gid = wgid / nig, fm = gid * WGM, gsz = (nM - fm) < WGM ? (nM - fm) : WGM;
        u.pm = fm + ((wgid % nig) % gsz); u.pn = (wgid % nig) / gsz; return true;
    }
    __device__ __forceinline__ void a_ready(const Unit&) const {}
    __device__ __forceinline__ void done(const Unit&) const {}
};

typedef f32x4 Acc[2][2][4][2];

__device__ __forceinline__ void row_stats(const float* st  , int row, int fq, float& mu, float& rstd) {
    const f32x4* p = (const f32x4*)(st + (size_t)row * 32 + 8 * fq);
    const f32x4 a = p[0], b = p[1];
    float s = (a.x + a.z) + (b.x + b.z), q = (a.y + a.w) + (b.y + b.w);
    s += __shfl_xor(s, 16); s += __shfl_xor(s, 32); q += __shfl_xor(q, 16); q += __shfl_xor(q, 32);
    mu = s * (1.0f / 1024.0f); const float var = fmaxf(q * (1.0f / 1024.0f) - mu * mu, 0.f); rstd = rsqrtf(var + LN_EPS);
}

struct EpiBf16 {
    static constexpr bool PERM = true;
    bf16_t* O; int ldc; float* ba; int ba_pn;
    __device__ __forceinline__ void operator()(const Acc& acc, const Unit& u, int wr, int wc, int fr, int fq) const {
        const int row0 = u.pm * BM + wr * 64 + fr;
        if (u.pn == ba_pn) {
            if (wc == 0 && fq < 2) {
#pragma unroll
                for (int ai = 0; ai < 2; ++ai)
#pragma unroll
                    for (int m = 0; m < 4; ++m) { float* p = ba + (size_t)(row0 + ai * HALF + m * 16) * 16 + 8 * fq; *(f32x4*)p = acc[ai][0][m][0]; *(f32x4*)(p + 4) = acc[ai][0][m][1]; }
            }
            return;
        }
        const int col0 = u.pn * BM + wc * 32 + 8 * fq;
#pragma unroll
        for (int ai = 0; ai < 2; ++ai)
#pragma unroll
            for (int m = 0; m < 4; ++m) { bf16_t* rowp = O + (size_t)(row0 + ai * HALF + m * 16) * ldc + col0;
#pragma unroll
                for (int bj = 0; bj < 2; ++bj) { const f32x4 v0 = acc[ai][bj][m][0], v1 = acc[ai][bj][m][1];
                    u32x4 w; w.x = pk2(v0[0], v0[1]); w.y = pk2(v0[2], v0[3]); w.z = pk2(v1[0], v1[1]); w.w = pk2(v1[2], v1[3]);
                    *(u32x4*)(rowp + bj * HALF) = w; } }
    }
};
struct EpiResStats {
    static constexpr bool PERM = true;
    bf16_t* X; float* st;
    __device__ __forceinline__ void operator()(const Acc& acc, const Unit& u, int wr, int wc, int fr, int fq) const {
        const int row0 = u.pm * BM + wr * 64 + fr, col0 = u.pn * BM + wc * 32 + 8 * fq;
#pragma unroll
        for (int ai = 0; ai < 2; ++ai)
#pragma unroll
            for (int m = 0; m < 4; ++m) { const int row = row0 + ai * HALF + m * 16; bf16_t* rowp = X + (size_t)row * D + col0; float s = 0.f, q = 0.f;
#pragma unroll
                for (int bj = 0; bj < 2; ++bj) { float x[8]; unpack8(*(const u32x4*)(rowp + bj * HALF), x); const f32x4 v0 = acc[ai][bj][m][0], v1 = acc[ai][bj][m][1];
#pragma unroll
                    for (int e = 0; e < 4; ++e) { x[e] = ALPHA * x[e] + v0[e]; x[4 + e] = ALPHA * x[4 + e] + v1[e]; }
#pragma unroll
                    for (int e = 0; e < 8; ++e) { s += x[e]; q += x[e] * x[e]; }
                    *(u32x4*)(rowp + bj * HALF) = pack8(x); }
                s += __shfl_xor(s, 16); s += __shfl_xor(s, 32); q += __shfl_xor(q, 16); q += __shfl_xor(q, 32);
                if (fq == 0) *(f32x2*)(st + ((size_t)row * 16 + u.pn * 4 + wc) * 2) = (f32x2){s, q}; }
    }
};
struct EpiLnResStats {
    static constexpr bool PERM = true;
    bf16_t* X; const float* st_in; float* st_out; const float* g; const float* b;
    __device__ __forceinline__ void operator()(const Acc& acc, const Unit& u, int wr, int wc, int fr, int fq) const {
        const int row0 = u.pm * BM + wr * 64 + fr, col0 = u.pn * BM + wc * 32 + 8 * fq;
        f32x4 gv[2][2], bv[2][2];
#pragma unroll
        for (int bj = 0; bj < 2; ++bj)
#pragma unroll
            for (int n = 0; n < 2; ++n) { gv[bj][n] = *(const f32x4*)(g + col0 + bj * HALF + 4 * n); bv[bj][n] = *(const f32x4*)(b + col0 + bj * HALF + 4 * n); }
#pragma unroll
        for (int ai = 0; ai < 2; ++ai)
#pragma unroll
            for (int m = 0; m < 4; ++m) { const int row = row0 + ai * HALF + m * 16; bf16_t* rowp = X + (size_t)row * D + col0; float s = 0.f, q = 0.f;
                float mu, rs; row_stats(st_in, row, fq, mu, rs);
#pragma unroll
                for (int bj = 0; bj < 2; ++bj) { float x[8]; unpack8(*(const u32x4*)(rowp + bj * HALF), x); const f32x4 v0 = acc[ai][bj][m][0], v1 = acc[ai][bj][m][1];
#pragma unroll
                    for (int e = 0; e < 4; ++e) { x[e] = ALPHA * ((x[e] - mu) * rs * gv[bj][0][e] + bv[bj][0][e]) + v0[e]; x[4 + e] = ALPHA * ((x[4 + e] - mu) * rs * gv[bj][1][e] + bv[bj][1][e]) + v1[e]; }
#pragma unroll
                    for (int e = 0; e < 8; ++e) { s += x[e]; q += x[e] * x[e]; }
                    *(u32x4*)(rowp + bj * HALF) = pack8(x); }
                s += __shfl_xor(s, 16); s += __shfl_xor(s, 32); q += __shfl_xor(q, 16); q += __shfl_xor(q, 32);
                if (fq == 0) *(f32x2*)(st_out + ((size_t)row * 16 + u.pn * 4 + wc) * 2) = (f32x2){s, q}; }
    }
};
struct EpiLnFold {
    static constexpr bool PERM = true;
    bf16_t* O; int ldc; const float* st; const float* c1; const float* c2;
    __device__ __forceinline__ void operator()(const Acc& acc, const Unit& u, int wr, int wc, int fr, int fq) const {
        const int row0 = u.pm * BM + wr * 64 + fr, col0 = u.pn * BM + wc * 32 + 8 * fq;
        f32x4 c1v[2][2], c2v[2][2];
#pragma unroll
        for (int bj = 0; bj < 2; ++bj)
#pragma unroll
            for (int n = 0; n < 2; ++n) { c1v[bj][n] = *(const f32x4*)(c1 + col0 + bj * HALF + 4 * n); c2v[bj][n] = *(const f32x4*)(c2 + col0 + bj * HALF + 4 * n); }
#pragma unroll
        for (int ai = 0; ai < 2; ++ai)
#pragma unroll
            for (int m = 0; m < 4; ++m) { const int row = row0 + ai * HALF + m * 16; bf16_t* rowp = O + (size_t)row * ldc + col0;
                float mu, rs; row_stats(st, row, fq, mu, rs);
#pragma unroll
                for (int bj = 0; bj < 2; ++bj) { const f32x4 v0 = (acc[ai][bj][m][0] - mu * c1v[bj][0]) * rs + c2v[bj][0], v1 = (acc[ai][bj][m][1] - mu * c1v[bj][1]) * rs + c2v[bj][1];
                    u32x4 w; w.x = pk2(v0[0], v0[1]); w.y = pk2(v0[2], v0[3]); w.z = pk2(v1[0], v1[1]); w.w = pk2(v1[2], v1[3]);
                    *(u32x4*)(rowp + bj * HALF) = w; } }
    }
};
struct EpiGate {
    static constexpr bool PERM = true;
    const bf16_t* H; const bf16_t* PP; bf16_t* XO; float* Y; const float* st; const float* c1; const float* c2; const float* g; const float* b;
    __device__ __forceinline__ void operator()(const Acc& acc, const Unit& u, int wr, int wc, int fr, int fq) const {
        const int row0 = u.pm * BM + wr * 64 + fr, col0 = u.pn * BM + wc * 32 + 8 * fq;
#pragma unroll
        for (int ai = 0; ai < 2; ++ai)
#pragma unroll
            for (int m = 0; m < 4; ++m) { const int row = row0 + ai * HALF + m * 16; const size_t off = (size_t)row * D + col0;
                float mu, rs; row_stats(st, row, fq, mu, rs);
#pragma unroll
                for (int bj = 0; bj < 2; ++bj) { float h[8], pp[8], o[8]; unpack8(*(const u32x4*)(H + off + bj * HALF), h); unpack8(*(const u32x4*)(PP + off + bj * HALF), pp);
#pragma unroll
                    for (int n = 0; n < 2; ++n) { const int cc = col0 + bj * HALF + 4 * n; const f32x4 c1v = *(const f32x4*)(c1 + cc), c2v = *(const f32x4*)(c2 + cc), gv = *(const f32x4*)(g + cc), bv = *(const f32x4*)(b + cc);
#pragma unroll
                        for (int e = 0; e < 4; ++e) { const float gate = (acc[ai][bj][m][n][e] - mu * c1v[e]) * rs + c2v[e]; const float x2 = (h[4 * n + e] - mu) * rs * gv[e] + bv[e];
                            o[4 * n + e] = x2 + pp[4 * n + e] * sigmoidf_(gate); } }
                    *(u32x4*)(XO + off + bj * HALF) = pack8(o);
                    if (Y) { *(f32x4*)(Y + off + bj * HALF) = (f32x4){o[0], o[1], o[2], o[3]}; *(f32x4*)(Y + off + bj * HALF + 4) = (f32x4){o[4], o[5], o[6], o[7]}; } } }
    }
};

template <class Epi, class Sched, bool ALIGN_EPI = true>
__device__ __forceinline__ void gemm_phase(LAS unsigned char* lds, const int tid, const Gemm g, const Sched& S, const Epi& E) {
    const int wid = __builtin_amdgcn_readfirstlane(tid >> 6), lane = tid & 63, wr = wid >> 2, wc = wid & 3, fr = lane & 15, fq = lane >> 4;
    const int K = g.K, nt = K / BK, lda = g.lda;
    unsigned voffA[2], voffB[2];
#pragma unroll
    for (int i = 0; i < 2; ++i) { int R, C; stage_rc(tid * 16 + i * 8192, R, C); const int Rb = Epi::PERM ? ((R & ~31) + perm32(R & 31)) : R;
        voffA[i] = (unsigned)(R * lda + C) * 2u; voffB[i] = (unsigned)(Rb * K + C) * 2u; }
    const size_t kstep = (size_t)(BK * 2);
    const size_t hstepA = (size_t)HALF * lda * 2, hstepB = (size_t)HALF * K * 2;
    const size_t tstepA = 2 * hstepA, tstepB = 2 * hstepB;
    const unsigned ldsw = (unsigned)wid * 1024u;
    const int aoff = lds_byte(wr * 64 + fr, fq * 8), boff = lds_byte(wc * 32 + fr, fq * 8);
#define PG8_SA(b, h) (((b) * 2 + (h)) * HTB)
#define PG8_SB(b, h) ((4 + (b) * 2 + (h)) * HTB)
#define PG8_STAGE(bufoff, gbase, voff) do { _Pragma("unroll") for (int _i = 0; _i < 2; ++_i) \
        __builtin_amdgcn_global_load_lds((const unsigned*)((const char*)(gbase) + (voff)[_i]), (LAS unsigned*)(lds + (bufoff) + ldsw + _i * 8192), 16, 0, 0); } while (0)
#define PG8_LDA(dst, b, h) do { _Pragma("unroll") for (int m = 0; m < 4; ++m) _Pragma("unroll") for (int k = 0; k < 2; ++k) dst[m][k] = *(const LAS bf16x8*)(lds + PG8_SA(b, h) + aoff + m * 2048 + k * 1024); } while (0)
#define PG8_LDB(dst, b, h) do { _Pragma("unroll") for (int n = 0; n < 2; ++n) _Pragma("unroll") for (int k = 0; k < 2; ++k) dst[n][k] = *(const LAS bf16x8*)(lds + PG8_SB(b, h) + boff + n * 2048 + k * 1024); } while (0)
#define PG8_MMA(ai, bj, At, Bt) do { __builtin_amdgcn_s_setprio(1); _Pragma("unroll") for (int m = 0; m < 4; ++m) _Pragma("unroll") for (int n = 0; n < 2; ++n) _Pragma("unroll") for (int k = 0; k < 2; ++k) \
        acc[ai][bj][m][n] = __builtin_amdgcn_mfma_f32_16x16x32_bf16(Bt[n][k], At[m][k], acc[ai][bj][m][n], 0, 0, 0); __builtin_amdgcn_s_setprio(0); } while (0)
#define PG8_WAIT_V(n) asm volatile("s_waitcnt vmcnt(" #n ")" ::: "memory")
#define PG8_WAIT_L(n) asm volatile("s_waitcnt lgkmcnt(" #n ")" ::: "memory")
#define PG8_BAR __builtin_amdgcn_s_barrier()
#define PG8_SCHED __builtin_amdgcn_sched_barrier(0)
    Unit cur, nxt; int ui = 0;
    if (!S.next(0, cur)) return;
    f32x4 acc[2][2][4][2];
#pragma unroll
    for (int a = 0; a < 2; ++a)
#pragma unroll
        for (int b = 0; b < 2; ++b)
#pragma unroll
            for (int m = 0; m < 4; ++m)
#pragma unroll
                for (int n = 0; n < 2; ++n) acc[a][b][m][n] = (f32x4){0.f, 0.f, 0.f, 0.f};
    bf16x8 At[4][2], B0[2][2], B1[2][2];
    const char* cA = (const char*)g.A + (size_t)cur.pm * tstepA; const char* cB = (const char*)g.Bt + (size_t)cur.pn * tstepB;
    S.a_ready(cur);
    PG8_STAGE(PG8_SB(0, 0), cB, voffB); PG8_STAGE(PG8_SB(0, 1), cB + hstepB, voffB); PG8_STAGE(PG8_SA(0, 0), cA, voffA); PG8_STAGE(PG8_SA(0, 1), cA + hstepA, voffA);
    if (wr == 1) PG8_BAR;
    PG8_WAIT_V(2); PG8_BAR;
    PG8_STAGE(PG8_SB(1, 0), cB + kstep, voffB); PG8_STAGE(PG8_SA(1, 0), cA + kstep, voffA); PG8_STAGE(PG8_SB(1, 1), cB + hstepB + kstep, voffB);
    PG8_WAIT_V(6); PG8_BAR;
    for (;;) {
        const bool has_next = S.next(ui + 1, nxt);
        const char* nA = has_next ? (const char*)g.A + (size_t)nxt.pm * tstepA : cA; const char* nB = has_next ? (const char*)g.Bt + (size_t)nxt.pn * tstepB : cB;
        for (int t = 0; t < nt; t += 2) {
            const bool last = (t == nt - 2);
            const char* a1 = cA + (size_t)(t + 1) * kstep;
            const char* a2 = last ? nA : cA + (size_t)(t + 2) * kstep; const char* b2 = last ? nB : cB + (size_t)(t + 2) * kstep;
            const char* a3 = a2 + kstep; const char* b3 = b2 + kstep;
            if (last && has_next) S.a_ready(nxt);
            PG8_LDB(B0, 0, 0); PG8_LDB(B1, 0, 1); PG8_SCHED; PG8_LDA(At, 0, 0); PG8_STAGE(PG8_SA(1, 1), a1 + hstepA, voffA);
            PG8_WAIT_V(8); PG8_WAIT_L(0); PG8_BAR; PG8_MMA(0, 0, At, B0); PG8_MMA(0, 1, At, B1); PG8_BAR; PG8_SCHED;
            PG8_LDA(At, 0, 1); PG8_STAGE(PG8_SB(0, 0), b2, voffB); PG8_STAGE(PG8_SB(0, 1), b2 + hstepB, voffB); PG8_STAGE(PG8_SA(0, 0), a2, voffA);
            PG8_WAIT_V(8); PG8_WAIT_L(0); PG8_BAR; PG8_MMA(1, 0, At, B0); PG8_MMA(1, 1, At, B1); PG8_BAR; PG8_SCHED;
            PG8_LDB(B0, 1, 0); PG8_LDB(B1, 1, 1); PG8_SCHED; PG8_LDA(At, 1, 0); PG8_STAGE(PG8_SA(0, 1), a2 + hstepA, voffA);
            PG8_WAIT_V(8); PG8_WAIT_L(0); PG8_BAR; PG8_MMA(0, 0, At, B0); PG8_MMA(0, 1, At, B1); PG8_BAR; PG8_SCHED;
            PG8_LDA(At, 1, 1); PG8_STAGE(PG8_SB(1, 0), b3, voffB); PG8_STAGE(PG8_SB(1, 1), b3 + hstepB, voffB); PG8_STAGE(PG8_SA(1, 0), a3, voffA);
            PG8_WAIT_V(8); PG8_WAIT_L(0); PG8_BAR; PG8_MMA(1, 0, At, B0); PG8_MMA(1, 1, At, B1); PG8_BAR; PG8_SCHED;
        }
        if constexpr (ALIGN_EPI) { if (wr == 0) PG8_BAR; }
        E(acc, cur, wr, wc, fr, fq); S.done(cur);
        if (!has_next) break;
#pragma unroll
        for (int a = 0; a < 2; ++a)
#pragma unroll
            for (int b = 0; b < 2; ++b)
#pragma unroll
                for (int m = 0; m < 4; ++m)
#pragma unroll
                    for (int n = 0; n < 2; ++n) acc[a][b][m][n] = (f32x4){0.f, 0.f, 0.f, 0.f};
        cur = nxt; cA = nA; cB = nB; ++ui;
        if constexpr (ALIGN_EPI) { if (wr == 1) PG8_BAR; }
    }
    PG8_WAIT_V(0);
    if constexpr (!ALIGN_EPI) { if (wr == 0) PG8_BAR; }
    PG8_BAR;
#undef PG8_SA
#undef PG8_SB
#undef PG8_STAGE
#undef PG8_LDA
#undef PG8_LDB
#undef PG8_MMA
#undef PG8_WAIT_V
#undef PG8_WAIT_L
#undef PG8_BAR
#undef PG8_SCHED
}
}

constexpr int NWAVES = 8, NTHR = NWAVES * 64;
constexpr int RING_BYTES = 131072, LDSCTL_OFF = RING_BYTES, MISC_OFF = LDSCTL_OFF + 320, LDS_BYTES = 147456;
typedef GAS unsigned gu32;
#define RLX_AGENT __ATOMIC_RELAXED, __HIP_MEMORY_SCOPE_AGENT

#define XB_TMO      128
#define XB_XCNT(j)  (256  + 64 * (j))
#define XB_XSUB(j)  (1280 + 64 * (j))
#define XB_XGEN(j)  (2304 + 64 * (j))
#define XB_TOP      3328
#define XB_TOPGEN   3392
#define XCD_BAR_WORDS 3456
#define XB_SPIN_CAP (1u << 18)
constexpr int CW_BAR = 4096;
__device__ __forceinline__ unsigned xb_ld(unsigned* p)              { return __hip_atomic_load(p, __ATOMIC_RELAXED, __HIP_MEMORY_SCOPE_AGENT); }
__device__ __forceinline__ unsigned xb_add(unsigned* p, unsigned v) { return __hip_atomic_fetch_add(p, v, __ATOMIC_RELAXED, __HIP_MEMORY_SCOPE_AGENT); }
__device__ __forceinline__ unsigned xb_xcc_id() { return (unsigned)__builtin_amdgcn_s_getreg((3 << 11) | 20) & 0xFu; }
#define XB_SPIN(cond, bar) do { unsigned _sp = 0; while (cond) { __builtin_amdgcn_s_sleep(1); \
    if ((++_sp & 255u) == 0u) { if (xb_ld(&(bar)[XB_TMO])) break; if (_sp > XB_SPIN_CAP) { atomicAdd(&(bar)[XB_TMO], 1u); break; } } } } while (0)
struct XcdBarrier { unsigned* bar; unsigned x; volatile LAS unsigned* st; };
__device__ __forceinline__ XcdBarrier xcd_barrier_post(unsigned* bar, volatile LAS unsigned* st) {
    XcdBarrier b; b.bar = bar; b.x = xb_xcc_id(); b.st = st;
    if (threadIdx.x == 0) (void)xb_add(&bar[XB_XCNT(b.x)], 1u);
    return b;
}
__device__ __forceinline__ void xcd_barrier_complete(unsigned* bar, unsigned x, unsigned& nloc, unsigned& nx) {
    const unsigned G = gridDim.x * gridDim.y * gridDim.z;
    unsigned sum, cnt, mine, sp = 0u;
    for (;;) {
        sum = 0u; cnt = 0u; mine = 0u;
#pragma unroll
        for (unsigned j = 0; j < 16; ++j) { const unsigned c = xb_ld(&bar[XB_XCNT(j)]); sum += c; cnt += (c > 0u) ? 1u : 0u; mine = (j == x) ? c : mine; }
        if (sum == G) break;
        __builtin_amdgcn_s_sleep(1);
        if ((++sp & 255u) == 0u) { if (xb_ld(&bar[XB_TMO])) break; if (sp > XB_SPIN_CAP) { atomicAdd(&bar[XB_TMO], 1u); break; } }
    }
    nloc = mine > 0u ? mine : 1u; nx = cnt > 0u ? cnt : 1u;
}
__device__ __forceinline__ void xcd_barrier(const XcdBarrier& b) {
    asm volatile("s_waitcnt vmcnt(0)" ::: "memory");
    __syncthreads();
    if (threadIdx.x == 0) {
        unsigned* bar = b.bar;
        __builtin_amdgcn_s_waitcnt(0);
        unsigned nloc = b.st[0], nx = b.st[1];
        if (nloc == 0u) { xcd_barrier_complete(bar, b.x, nloc, nx); b.st[0] = nloc; b.st[1] = nx; }
        const unsigned old = xb_add(&bar[XB_XSUB(b.x)], 1u);
        const unsigned gen = old / nloc;
        if (old + 1u == (gen + 1u) * nloc) {
            __builtin_amdgcn_fence(__ATOMIC_RELEASE, "agent");
            asm volatile("s_waitcnt vmcnt(0)" ::: "memory");
            const unsigned og = xb_add(&bar[XB_TOP], 1u);
            const unsigned tg = og / nx;
            if (og + 1u == (tg + 1u) * nx) xb_add(&bar[XB_TOPGEN], 1u);
            else XB_SPIN(xb_ld(&bar[XB_TOPGEN]) == tg, bar);
            __builtin_amdgcn_fence(__ATOMIC_ACQUIRE, "agent");
            xb_add(&bar[XB_XGEN(b.x)], 1u);
            asm volatile("s_waitcnt vmcnt(0)" ::: "memory");
        } else {
            XB_SPIN(xb_ld(&bar[XB_XGEN(b.x)]) == gen, bar);
            __builtin_amdgcn_fence(__ATOMIC_ACQUIRE, "agent");
            asm volatile("s_waitcnt vmcnt(0)" ::: "memory");
        }
    }
    __syncthreads();
}

struct Args {
    const float* in[26]; float* out; unsigned char* ws; int ph_lo, ph_hi;
};
struct Frame {
    LAS unsigned char* lds; int tid, lane, wave, vcu, G;
};
typedef const __attribute__((address_space(4))) Args* KArgs;
__device__ __forceinline__ bf16_t* wl_base(KArgs a, int l) {
    return l < 2 ? (bf16_t*)(a->out + O_SDNS + (size_t)NB_S * NH * HD * HD) + (size_t)l * WL_SIZE : (bf16_t*)(a->ws + WS_W23) + (size_t)(l - 2) * WL_SIZE;
}
__device__ __forceinline__ float* vec_base(KArgs a, int l) { return (float*)(a->ws + WS_VEC) + (size_t)l * VEC_L; }

__device__ __forceinline__ void p0_transpose_item(const float* W, int K, int N, int ldn, const float* gk, bf16_t* WT, LAS float* scr, int item, int nblk, int lane) {
    const int kb = item / nblk, nb = item % nblk, k0 = 64 * kb, n0 = 32 * nb;
    const int nq = lane & 7, n = n0 + 4 * nq, kr = lane >> 3;
    f32x4 v[8];
#pragma unroll
    for (int i = 0; i < 8; ++i) v[i] = (n < N) ? *(const f32x4*)(W + (size_t)(k0 + kr + 8 * i) * ldn + n) : (f32x4){0.f, 0.f, 0.f, 0.f};
#pragma unroll
    for (int i = 0; i < 8; ++i) { const int kk = kr + 8 * i; if (gk) v[i] = v[i] * gk[k0 + kk];
#pragma unroll
        for (int e = 0; e < 4; ++e) scr[kk * 33 + 4 * nq + e] = v[i][e]; }
    asm volatile("s_waitcnt lgkmcnt(0)" ::: "memory");
    const int c = lane & 7;
#pragma unroll
    for (int j = 0; j < 4; ++j) { const int nn = (lane >> 3) + 8 * j; const LAS float* s = scr + (8 * c) * 33 + nn;
        u32x4 o; o.x = cvtpk(s[0 * 33], s[1 * 33]); o.y = cvtpk(s[2 * 33], s[3 * 33]); o.z = cvtpk(s[4 * 33], s[5 * 33]); o.w = cvtpk(s[6 * 33], s[7 * 33]);
        *(u32x4*)(WT + (size_t)(n0 + nn) * K + k0 + 8 * c) = o; }
    asm volatile("s_waitcnt lgkmcnt(0)" ::: "memory");
}
__device__ __forceinline__ void p0_transpose(const Frame& F, const float* W, int K, int N, int Npad, const float* gk, bf16_t* WT) {
    LAS float* scr = (LAS float*)(F.lds + F.wave * 16384);
    const int gw = F.vcu * NWAVES + F.wave, NGW = F.G * NWAVES, nblk = Npad / 32, nitems = (K / 64) * nblk;
    for (int it = gw; it < nitems; it += NGW) p0_transpose_item(W, K, N, N, gk, WT, scr, it, nblk, F.lane);
}
__device__ __forceinline__ void p0_prologue(const Frame& F, KArgs a) {
    for (int l = 0; l < DEPTH; ++l) {
        bf16_t* wb = wl_base(a, l); const int j = l >> 1;
        if ((l & 1) == 0) { p0_transpose(F, a->in[8] + (size_t)j * D * AIN, D, AIN, 4352, nullptr, wb + WL_IN); p0_transpose(F, a->in[13] + (size_t)j * D * D, D, D, D, nullptr, wb + WL_OUT); }
        else { p0_transpose(F, a->in[14] + (size_t)j * D * 3 * D, D, 3 * D, 3 * D, nullptr, wb + WL_IN); p0_transpose(F, a->in[16] + (size_t)j * D * D, D, D, D, nullptr, wb + WL_OUT); }
        p0_transpose(F, a->in[17] + (size_t)l * D * DFF2, D, DFF2, DFF2, a->in[20] + l * D, wb + WL_UP);
        p0_transpose(F, a->in[19] + (size_t)l * DFF * D, DFF, D, D, nullptr, wb + WL_DOWN);
        p0_transpose(F, a->in[25] + (size_t)l * D * D, D, D, D, a->in[22] + l * D, wb + WL_G);
        p0_transpose(F, a->in[24] + (size_t)l * DPLE * D, DPLE, D, D, nullptr, wb + WL_P);
    }
    const int gt = F.vcu * NTHR + F.tid, NGT = F.G * NTHR;
    {
        LAS float* red = (LAS float*)(F.lds + NWAVES * 16384 - 8192);
        constexpr int NBLK = (DFF2 + D) / 64;
        for (int it = F.vcu; it < DEPTH * NBLK; it += F.G) {
            const int l = it / NBLK, n0 = (it % NBLK) * 64; const bool up = n0 < DFF2; const int n = (up ? n0 : n0 - DFF2) + F.lane, N = up ? DFF2 : D;
            const float* W = (up ? a->in[17] + (size_t)l * D * DFF2 : a->in[25] + (size_t)l * D * D) + n;
            const float* g = (up ? a->in[20] : a->in[22]) + l * D; const float* b = (up ? a->in[21] : a->in[23]) + l * D;
            float s1 = 0.f, s2 = 0.f; const int k0 = 128 * F.wave;
#pragma unroll 16
            for (int k = k0; k < k0 + 128; ++k) { const float w = W[(size_t)k * N]; s1 += bf2f(f2bf(g[k] * w)); s2 += b[k] * w; }
            __syncthreads();
            red[(F.wave * 64 + F.lane) * 2] = s1; red[(F.wave * 64 + F.lane) * 2 + 1] = s2;
            __syncthreads();
            if (F.tid < 128) { const int c = F.tid >> 1, which = F.tid & 1; float t = 0.f;
#pragma unroll
                for (int w8 = 0; w8 < 8; ++w8) t += red[(w8 * 64 + c) * 2 + which];
                float* vb = vec_base(a, l); const int nn = (up ? n0 : n0 - DFF2) + c;
                vb[(up ? 0 : 2 * DFF2) + (which ? (up ? DFF2 : D) : 0) + nn] = t; }
        }
        __syncthreads();
    }
    bf16_t* X0 = (bf16_t*)(a->ws + WS_X0); bf16_t* PB = (bf16_t*)(a->ws + WS_PB);
#pragma unroll 4
    for (size_t i = gt; i < (size_t)M * D / 8; i += NGT) { const size_t e = i * 8; const float* src = e < (size_t)M_P * D ? a->in[0] + e : a->in[1] + (e - (size_t)M_P * D);
        const f32x4 v0 = *(const f32x4*)src, v1 = *(const f32x4*)(src + 4); u32x4 w; w.x = pk2(v0[0], v0[1]); w.y = pk2(v0[2], v0[3]); w.z = pk2(v1[0], v1[1]); w.w = pk2(v1[2], v1[3]); *(u32x4*)(X0 + e) = w; }
#pragma unroll 4
    for (size_t i = gt; i < (size_t)DEPTH * M * DPLE / 8; i += NGT) { const size_t e = i * 8; const size_t l = e / ((size_t)M * DPLE), r = e % ((size_t)M * DPLE);
        const float* src = r < (size_t)M_P * DPLE ? a->in[2] + l * (size_t)M_P * DPLE + r : a->in[3] + l * (size_t)M_S * DPLE + (r - (size_t)M_P * DPLE);
        const f32x4 v0 = *(const f32x4*)src, v1 = *(const f32x4*)(src + 4); u32x4 w; w.x = pk2(v0[0], v0[1]); w.y = pk2(v0[2], v0[3]); w.z = pk2(v1[0], v1[1]); w.w = pk2(v1[2], v1[3]); *(u32x4*)(PB + e) = w; }
}

__device__ __forceinline__ void dn_chunk_phase(const Frame& F, KArgs a, int j) {
    const bf16_t* proj = (const bf16_t*)(a->ws + WS_R1); const float* ba = (const float*)(a->ws + WS_BA);
    const float* cw = a->in[9] + (size_t)j * 4 * QKV;
    LAS float* Am = (LAS float*)(F.lds);
    LAS float* sc = (LAS float*)(F.lds + 17408);
    LAS unsigned char* kn = F.lds + 18432;
    LAS unsigned char* qn = F.lds + 35840;
    LAS float* vv = (LAS float*)(F.lds + 53248);
    LAS unsigned char* wb = F.lds + 86016;
    const int tid = F.tid, lane = F.lane, wave = F.wave;
    for (int cu = F.vcu; cu < N_CU; cu += F.G) {
        const int n = cu & 31, h = (cu >> 5) & 7, b = cu >> 8, rowbase = b * SEQ + n * 64;
        unsigned char* cub = a->ws + WS_R2 + (size_t)cu * CU_BYTES;
        if (wave == 0) {
            const int r = rowbase + lane;
            const float b1 = ba[(size_t)r * 16 + h], b2 = ba[(size_t)r * 16 + 8 + h] + a->in[11][j * 8 + h];
            const float sp = b2 > 20.f ? b2 : log1pf(expf(b2));
            float c = -expf(a->in[10][j * 8 + h]) * sp;
#pragma unroll
            for (int o = 1; o < 64; o <<= 1) { const float t = __shfl_up(c, o); if (lane >= o) c += t; }
            const float gl = __shfl(c, 63);
            sc[lane] = c; sc[64 + lane] = sigmoidf_(b1); sc[128 + lane] = __expf(c); sc[192 + lane] = __expf(gl - c);
            if (lane == 0) ((float*)(a->ws + WS_R2 + R2_DEC))[cu] = __expf(gl);
        }
        __syncthreads();
#pragma unroll 1
        for (int crep = 0; crep < MK_CONV_REP; ++crep)
        if (tid < 384) {
            const int tb = tid / 48, pg = tid % 48, part = pg >> 4, g8 = pg & 15, col = part * 1024 + h * HD + 8 * g8, t0 = n * 64 + 8 * tb, r0 = rowbase + 8 * tb;
            u32x4 raw[11];
#pragma unroll
            for (int q = 0; q < 11; ++q) raw[q] = (t0 + q - 3 >= 0) ? *(const u32x4*)(proj + (size_t)(r0 + q - 3) * PROJW + col) : (u32x4){0u, 0u, 0u, 0u};
            f32x4 wv[4][2];
#pragma unroll
            for (int jj = 0; jj < 4; ++jj) { wv[jj][0] = *(const f32x4*)(cw + (size_t)jj * QKV + col); wv[jj][1] = *(const f32x4*)(cw + (size_t)jj * QKV + col + 4); }
#pragma unroll
            for (int e = 0; e < 8; ++e) {
                const int tok = 8 * tb + e; float y[8];
#pragma unroll
                for (int c = 0; c < 8; ++c) y[c] = 0.f;
#pragma unroll
                for (int jj = 0; jj < 4; ++jj) { float u[8]; unpack8(raw[e + jj], u);
#pragma unroll
                    for (int c = 0; c < 4; ++c) { y[c] += wv[jj][0][c] * u[c]; y[4 + c] += wv[jj][1][c] * u[4 + c]; }
                    if (jj == 3 && t0 + e >= SEQ - 3) { float* o = a->out + O_PDNC + (((size_t)j * NB_P + b) * 3 + (t0 + e - (SEQ - 3))) * QKV + col;
                        *(f32x4*)o = (f32x4){u[0], u[1], u[2], u[3]}; *(f32x4*)(o + 4) = (f32x4){u[4], u[5], u[6], u[7]}; } }
                float ss = 0.f;
#pragma unroll
                for (int c = 0; c < 8; ++c) { y[c] = siluf_(y[c]); ss += y[c] * y[c]; }
                if (part < 2) {
                    ss += __shfl_xor(ss, 1); ss += __shfl_xor(ss, 2); ss += __shfl_xor(ss, 4); ss += __shfl_xor(ss, 8);
                    const float sl = rsqrtf(ss + L2_EPS) * (part == 0 ? QSCALE : 1.0f);
                    u32x4 w; w.x = cvtpk(y[0] * sl, y[1] * sl); w.y = cvtpk(y[2] * sl, y[3] * sl); w.z = cvtpk(y[4] * sl, y[5] * sl); w.w = cvtpk(y[6] * sl, y[7] * sl);
                    *(LAS u32x4*)((part == 0 ? qn : kn) + tok * 272 + g8 * 16) = w;
                } else {
                    const float bt = sc[64 + tok];
                    *(LAS f32x4*)(vv + tok * 128 + 8 * g8) = (f32x4){y[0] * bt, y[1] * bt, y[2] * bt, y[3] * bt}; *(LAS f32x4*)(vv + tok * 128 + 8 * g8 + 4) = (f32x4){y[4] * bt, y[5] * bt, y[6] * bt, y[7] * bt};
                }
            }
        }
        __syncthreads();
        if (wave < 6) {
            const int kind = wave >= 3, pr = wave - 3 * kind, mj = pr == 2, mi = pr >= 1, r32 = lane & 31, hh = lane >> 5;
            f32x16 acc;
#pragma unroll
            for (int e = 0; e < 16; ++e) acc[e] = 0.f;
            const LAS unsigned char* ap = kn + (32 * mj + r32) * 272 + hh * 16; const LAS unsigned char* bp = (kind ? qn : kn) + (32 * mi + r32) * 272 + hh * 16;
#pragma unroll
            for (int s = 0; s < 8; ++s) acc = __builtin_amdgcn_mfma_f32_32x32x16_bf16(*(const LAS bf16x8*)(ap + 32 * s), *(const LAS bf16x8*)(bp + 32 * s), acc, 0, 0, 0);
            const int i = 32 * mi + r32; const float gci = sc[i], bi = sc[64 + i];
            if (kind == 0) {
#pragma unroll
                for (int q4 = 0; q4 < 4; ++q4) { const int j0 = 32 * mj + 8 * q4 + 4 * hh; f32x4 o;
#pragma unroll
                    for (int e = 0; e < 4; ++e) { const int jj = j0 + e; o[e] = (i > jj) ? bi * acc[4 * q4 + e] * __expf(fminf(gci - sc[jj], 0.f)) : 0.f; }
                    *(LAS f32x4*)(Am + i * 68 + j0) = o; }
            } else {
#pragma unroll
                for (int s = 0; s < 2; ++s) { float v[8];
#pragma unroll
                    for (int e = 0; e < 8; ++e) { const int jj = 32 * mj + crow(8 * s + e, hh); v[e] = (i >= jj) ? acc[8 * s + e] * __expf(fminf(gci - sc[jj], 0.f)) : 0.f; }
                    u32x4 w; w.x = cvtpk(v[0], v[1]); w.y = cvtpk(v[2], v[3]); w.z = cvtpk(v[4], v[5]); w.w = cvtpk(v[6], v[7]);
                    *(u32x4*)(cub + CU_AF + (pr * 2 + s) * 1024 + lane * 16) = w; }
            }
        }
        __syncthreads();
        if (wave < 4) {
#pragma unroll 1
            for (int srep = 0; srep < MK_SUB_REP; ++srep) {
            float X[64];
            if (wave < 2) {
#pragma unroll
                for (int i = 0; i < 64; ++i) X[i] = vv[i * 128 + 64 * wave + lane];
            } else {
#pragma unroll
                for (int i = 0; i < 64; ++i) X[i] = bf2f(*(const LAS unsigned short*)(kn + i * 272 + (64 * (wave - 2) + lane) * 2)) * (sc[64 + i] * sc[128 + i]);
            }
            f32x4 ring[3][8]; float a0 = 0.f, a1 = 0.f;
#define HR_ROW(s) ((s) < 32 ? (s) + 1 : 33 + (((s) - 32) >> 1))
#define HR_HALF(s) ((s) < 32 ? 0 : (((s) - 32) & 1))
#define HR_LOAD(s) do { const int i_ = HR_ROW(s), h_ = HR_HALF(s), c0_ = 32 * h_, c1_ = h_ ? i_ : (i_ < 32 ? i_ : 32); \
                _Pragma("unroll") for (int q = 0; q < (c1_ - c0_ + 3) / 4; ++q) ring[(s) % 3][q] = *(const LAS f32x4*)(Am + i_ * 68 + c0_ + 4 * q); } while (0)
            HR_LOAD(0); HR_LOAD(1);
#pragma unroll
            for (int sI = 0; sI < 94; ++sI) {
                if (sI + 2 < 94) HR_LOAD(sI + 2);
                __builtin_amdgcn_sched_barrier(0);
                const int i = HR_ROW(sI), hf = HR_HALF(sI), c0 = 32 * hf, c1 = hf ? i : (i < 32 ? i : 32);
                if (hf == 0) { a0 = X[i]; a1 = 0.f; }
#pragma unroll
                for (int j4 = c0; j4 < c1; j4 += 4) { const f32x4 av = ring[sI % 3][(j4 - c0) >> 2];
                    a0 -= av[0] * X[j4]; if (j4 + 1 < c1) a1 -= av[1] * X[j4 + 1]; if (j4 + 2 < c1) a0 -= av[2] * X[j4 + 2]; if (j4 + 3 < c1) a1 -= av[3] * X[j4 + 3]; }
                if (hf == 1 || i <= 32) X[i] = a0 + a1;
                __builtin_amdgcn_sched_barrier(0);
            }
#undef HR_ROW
#undef HR_HALF
#undef HR_LOAD
            if (wave < 2) { float* U = (float*)(cub + CU_U) + 64 * wave + lane;
#pragma unroll
                for (int i = 0; i < 64; ++i) U[i * 128] = X[i];
            } else {
#pragma unroll
                for (int i = 0; i < 64; ++i) *(LAS unsigned short*)(wb + i * 272 + (64 * (wave - 2) + lane) * 2) = (unsigned short)f2bf(X[i]);
            }
            }
        } else {
            const int t2 = tid - 256;
#pragma unroll 1
            for (int k = 0; k < 4; ++k) { const int vi = t2 + 256 * k, f = vi >> 6, ln = vi & 63, r32 = ln & 31, hh = ln >> 5;
                { const int mtok = f >> 3, mt = (f >> 1) & 3, s = f & 1, tok = 32 * mtok + r32, kd0 = 32 * mt + 16 * s + 4 * hh; const float eg = sc[128 + tok];
                  const u32x2 lo = *(const LAS u32x2*)(qn + tok * 272 + kd0 * 2), hi = *(const LAS u32x2*)(qn + tok * 272 + (kd0 + 8) * 2);
                  u32x4 w; w.x = cvtpk(bf2f(lo.x & 0xffffu) * eg, bf2f(lo.x >> 16) * eg); w.y = cvtpk(bf2f(lo.y & 0xffffu) * eg, bf2f(lo.y >> 16) * eg);
                  w.z = cvtpk(bf2f(hi.x & 0xffffu) * eg, bf2f(hi.x >> 16) * eg); w.w = cvtpk(bf2f(hi.y & 0xffffu) * eg, bf2f(hi.y >> 16) * eg);
                  *(u32x4*)(cub + CU_QF + f * 1024 + ln * 16) = w; }
                { const int mt = f >> 2, mtok = (f >> 1) & 1, s = f & 1, kd = 32 * mt + r32; float v[8];
#pragma unroll
                  for (int e = 0; e < 8; ++e) { const int tk = 32 * mtok + 16 * s + 8 * (e >> 2) + 4 * hh + (e & 3); v[e] = bf2f(*(const LAS unsigned short*)(kn + tk * 272 + kd * 2)) * sc[192 + tk]; }
                  u32x4 w; w.x = cvtpk(v[0], v[1]); w.y = cvtpk(v[2], v[3]); w.z = cvtpk(v[4], v[5]); w.w = cvtpk(v[6], v[7]);
                  *(u32x4*)(cub + CU_KF + f * 1024 + ln * 16) = w; }
            }
        }
        __syncthreads();
#pragma unroll 1
        for (int k = 0; k < 2; ++k) { const int vi = tid + 512 * k, f = vi >> 6, ln = vi & 63, r32 = ln & 31, hh = ln >> 5;
            const int mtok = f >> 3, mt = (f >> 1) & 3, s = f & 1, tok = 32 * mtok + r32, kd0 = 32 * mt + 16 * s + 4 * hh;
            const u32x2 lo = *(const LAS u32x2*)(wb + tok * 272 + kd0 * 2), hi = *(const LAS u32x2*)(wb + tok * 272 + (kd0 + 8) * 2);
            *(u32x4*)(cub + CU_WF + f * 1024 + ln * 16) = (u32x4){lo.x, lo.y, hi.x, hi.y}; }
        __syncthreads();
    }
}

__device__ __forceinline__ void dn_scan_unit(const Frame& F, KArgs a, int j, int bh) {
    const int w = F.wave, lane = F.lane;
    const unsigned char* cub = a->ws + WS_R2 + (size_t)bh * 32 * CU_BYTES;
    if (w >= 4) {
        const int lw = w - 4;
        for (int n = 0; n <= 32; ++n) {
            if (n < 32) { const unsigned char* src = cub + (size_t)n * CU_BYTES + lane * 16; LAS unsigned char* dst = F.lds + (n & 1) * CU_LDS;
                for (int pc = lw; pc < 54; pc += 4) __builtin_amdgcn_global_load_lds((const unsigned*)(src + pc * 1024), (LAS unsigned*)(dst + pc * 1024), 16, 0, 0); }
            asm volatile("s_waitcnt vmcnt(0)" ::: "memory");
            __syncthreads();
        }
    } else {
        const int v = lane & 31, hh = lane >> 5, b = bh >> 3, h = bh & 7;
        f32x16 S[4];
#pragma unroll
        for (int mt = 0; mt < 4; ++mt)
#pragma unroll
            for (int e = 0; e < 16; ++e) S[mt][e] = 0.f;
        const float* decp = (const float*)(a->ws + WS_R2 + R2_DEC) + bh * 32;
        float* Og = (float*)(a->ws + WS_R1);
        __syncthreads();
        for (int n = 0; n < 32; ++n) {
            const LAS unsigned char* buf = F.lds + (n & 1) * CU_LDS + lane * 16;
            const float* U = (const float*)(cub + (size_t)n * CU_BYTES + CU_U) + 32 * w + v;
            f32x16 un[2];
#pragma unroll
            for (int mtok = 0; mtok < 2; ++mtok)
#pragma unroll
                for (int e = 0; e < 16; ++e) un[mtok][e] = U[(32 * mtok + crow(e, hh)) * 128];
            const float dec = decp[n];
            bf16x8 Sb[4][2];
#pragma unroll
            for (int mt = 0; mt < 4; ++mt)
#pragma unroll
                for (int s = 0; s < 2; ++s) { u32x4 p; p.x = cvtpk(S[mt][8 * s], S[mt][8 * s + 1]); p.y = cvtpk(S[mt][8 * s + 2], S[mt][8 * s + 3]); p.z = cvtpk(S[mt][8 * s + 4], S[mt][8 * s + 5]); p.w = cvtpk(S[mt][8 * s + 6], S[mt][8 * s + 7]);
                    Sb[mt][s] = __builtin_bit_cast(bf16x8, p); }
            f32x16 acc[2];
#pragma unroll
            for (int mtok = 0; mtok < 2; ++mtok) {
#pragma unroll
                for (int e = 0; e < 16; ++e) acc[mtok][e] = 0.f;
#pragma unroll
                for (int mt = 0; mt < 4; ++mt)
#pragma unroll
                    for (int s = 0; s < 2; ++s) acc[mtok] = __builtin_amdgcn_mfma_f32_32x32x16_bf16(*(const LAS bf16x8*)(buf + CU_WF + ((mtok * 4 + mt) * 2 + s) * 1024), Sb[mt][s], acc[mtok], 0, 0, 0);
            }
            bf16x8 vnb[2][2];
#pragma unroll
            for (int mtok = 0; mtok < 2; ++mtok) {
#pragma unroll
                for (int e = 0; e < 16; ++e) acc[mtok][e] = un[mtok][e] - acc[mtok][e];
#pragma unroll
                for (int s = 0; s < 2; ++s) { u32x4 p; p.x = cvtpk(acc[mtok][8 * s], acc[mtok][8 * s + 1]); p.y = cvtpk(acc[mtok][8 * s + 2], acc[mtok][8 * s + 3]); p.z = cvtpk(acc[mtok][8 * s + 4], acc[mtok][8 * s + 5]); p.w = cvtpk(acc[mtok][8 * s + 6], acc[mtok][8 * s + 7]);
                    vnb[mtok][s] = __builtin_bit_cast(bf16x8, p); }
            }
#pragma unroll
            for (int mtok = 0; mtok < 2; ++mtok) {
                f32x16 o;
#pragma unroll
                for (int e = 0; e < 16; ++e) o[e] = 0.f;
#pragma unroll
                for (int mt = 0; mt < 4; ++mt)
#pragma unroll
                    for (int s = 0; s < 2; ++s) o = __builtin_amdgcn_mfma_f32_32x32x16_bf16(*(const LAS bf16x8*)(buf + CU_QF + ((mtok * 4 + mt) * 2 + s) * 1024), Sb[mt][s], o, 0, 0, 0);
#pragma unroll
                for (int mp = 0; mp <= mtok; ++mp)
#pragma unroll
                    for (int s = 0; s < 2; ++s) o = __builtin_amdgcn_mfma_f32_32x32x16_bf16(*(const LAS bf16x8*)(buf + CU_AF + ((mtok + mp) * 2 + s) * 1024), vnb[mp][s], o, 0, 0, 0);
                float* op = Og + (size_t)(b * SEQ + n * 64 + 32 * mtok) * OLD + h * HD + 32 * w + v;
#pragma unroll
                for (int e = 0; e < 16; ++e) op[(size_t)crow(e, hh) * OLD] = o[e];
            }
#pragma unroll
            for (int mt = 0; mt < 4; ++mt) {
#pragma unroll
                for (int e = 0; e < 16; ++e) S[mt][e] *= dec;
#pragma unroll
                for (int mtok = 0; mtok < 2; ++mtok)
#pragma unroll
                    for (int s = 0; s < 2; ++s) S[mt] = __builtin_amdgcn_mfma_f32_32x32x16_bf16(*(const LAS bf16x8*)(buf + CU_KF + ((mt * 2 + mtok) * 2 + s) * 1024), vnb[mtok][s], S[mt], 0, 0, 0);
            }
            __syncthreads();
        }
        float* so = a->out + O_PDNS + ((size_t)j * NB_P * NH + bh) * HD * HD + 32 * w + v;
#pragma unroll
        for (int mt = 0; mt < 4; ++mt)
#pragma unroll
            for (int e = 0; e < 16; ++e) so[(size_t)(32 * mt + crow(e, hh)) * HD] = S[mt][e];
    }
}

__device__ __forceinline__ void dn_sample_unit(const Frame& F, KArgs a, int j, int u) {
    const int tid = F.tid, b = u >> 3, h = u & 7, row0 = M_P + b * DSEQ;
    const bf16_t* proj = (const bf16_t*)(a->ws + WS_R1); const float* ba = (const float*)(a->ws + WS_BA);
    const float* cw = a->in[9] + (size_t)j * 4 * QKV; const float* sbuf = a->in[4] + ((size_t)j * NB_S + b) * 3 * QKV;
    LAS float* qn = (LAS float*)F.lds;
    LAS float* kn = qn + 1024;
    LAS float* vb = kn + 1024;
    LAS float* ul = vb + 1024;
    LAS float* wl = ul + 1024;
    LAS float* vn = wl + 1024;
    LAS float* A8 = vn + 1024;
    LAS float* T8 = A8 + 64;
    LAS float* sc = T8 + 64;
    LAS float* red = sc + 64;
    __syncthreads();
    if (tid < 8) {
        const int r = row0 + tid;
        const float b1 = ba[(size_t)r * 16 + h], b2 = ba[(size_t)r * 16 + 8 + h] + a->in[11][j * 8 + h];
        const float sp = b2 > 20.f ? b2 : log1pf(expf(b2));
        float c = -expf(a->in[10][j * 8 + h]) * sp;
#pragma unroll
        for (int o = 1; o < 8; o <<= 1) { const float t = __shfl_up(c, o); if (tid >= o) c += t; }
        const float gl = __shfl(c, 7);
        sc[tid] = c; sc[8 + tid] = sigmoidf_(b1); sc[16 + tid] = __expf(c); sc[24 + tid] = __expf(gl - c); if (tid == 0) sc[32] = __expf(gl);
    }
    __syncthreads();
    if (tid < 384) {
        const int rr = tid >> 4, part = rr >> 3, tok = rr & 7, g8 = tid & 15, col = part * 1024 + h * HD + 8 * g8, r = row0 + tok;
        float y[8];
#pragma unroll
        for (int e = 0; e < 8; ++e) y[e] = 0.f;
#pragma unroll
        for (int jj = 0; jj < 4; ++jj) { const int d = 3 - jj; float uu[8];
            if (tok - d >= 0) unpack8(*(const u32x4*)(proj + (size_t)(r - d) * PROJW + col), uu);
            else { const float* p = sbuf + (size_t)(tok + jj) * QKV + col;
#pragma unroll
                for (int e = 0; e < 8; ++e) uu[e] = p[e]; }
            const f32x4 w0 = *(const f32x4*)(cw + (size_t)jj * QKV + col), w1 = *(const f32x4*)(cw + (size_t)jj * QKV + col + 4);
#pragma unroll
            for (int e = 0; e < 4; ++e) { y[e] += w0[e] * uu[e]; y[4 + e] += w1[e] * uu[4 + e]; }
            if (jj == 3 && tok >= DSEQ - 3) { float* o = a->out + O_SDNC + (((size_t)j * NB_S + b) * 3 + (tok - (DSEQ - 3))) * QKV + col;
                *(f32x4*)o = (f32x4){uu[0], uu[1], uu[2], uu[3]}; *(f32x4*)(o + 4) = (f32x4){uu[4], uu[5], uu[6], uu[7]}; } }
        float ss = 0.f;
#pragma unroll
        for (int e = 0; e < 8; ++e) { y[e] = siluf_(y[e]); ss += y[e] * y[e]; }
        ss += __shfl_xor(ss, 1); ss += __shfl_xor(ss, 2); ss += __shfl_xor(ss, 4); ss += __shfl_xor(ss, 8);
        const float sl = part == 0 ? rsqrtf(ss + L2_EPS) * QSCALE : (part == 1 ? rsqrtf(ss + L2_EPS) : sc[8 + tok]);
        LAS float* dst = (part == 0 ? qn : (part == 1 ? kn : vb)) + tok * 128 + 8 * g8;
        *(LAS f32x4*)dst = (f32x4){y[0] * sl, y[1] * sl, y[2] * sl, y[3] * sl}; *(LAS f32x4*)(dst + 4) = (f32x4){y[4] * sl, y[5] * sl, y[6] * sl, y[7] * sl};
    }
    __syncthreads();
    {
        const int d = tid >> 3, i = d >> 3, jx = d & 7, sub = tid & 7; float kk = 0.f, qk = 0.f;
#pragma unroll
        for (int e = 0; e < 16; ++e) { const float kj = kn[jx * 128 + 16 * sub + e]; kk += kn[i * 128 + 16 * sub + e] * kj; qk += qn[i * 128 + 16 * sub + e] * kj; }
        kk += __shfl_xor(kk, 1); kk += __shfl_xor(kk, 2); kk += __shfl_xor(kk, 4); qk += __shfl_xor(qk, 1); qk += __shfl_xor(qk, 2); qk += __shfl_xor(qk, 4);
        if (sub == 0) { const float dc = __expf(fminf(sc[i] - sc[jx], 0.f)); A8[d] = i > jx ? sc[8 + i] * kk * dc : 0.f; T8[d] = i >= jx ? qk * dc : 0.f; }
    }
    __syncthreads();
    if (tid < 256) {
        const int c = tid & 127, isw = tid >> 7; float X[8];
#pragma unroll
        for (int i = 0; i < 8; ++i) X[i] = isw ? kn[i * 128 + c] * sc[8 + i] * sc[16 + i] : vb[i * 128 + c];
#pragma unroll
        for (int i = 1; i < 8; ++i)
#pragma unroll
            for (int jx = 0; jx < i; ++jx) X[i] -= A8[i * 8 + jx] * X[jx];
        LAS float* dst = isw ? wl : ul;
#pragma unroll
        for (int i = 0; i < 8; ++i) dst[i * 128 + c] = X[i];
    }
    __syncthreads();
    const int v = tid & 127, kq = tid >> 7;
    float S[32];
    { const float* s0 = a->in[5] + (((size_t)j * NB_S + b) * NH + h) * HD * HD + (size_t)(32 * kq) * HD + v;
#pragma unroll
      for (int i = 0; i < 32; ++i) S[i] = s0[(size_t)i * HD]; }
#pragma unroll
    for (int c = 0; c < 8; ++c) { float pw = 0.f, pq = 0.f;
#pragma unroll
        for (int i4 = 0; i4 < 32; i4 += 4) { const f32x4 wv = *(const LAS f32x4*)(wl + c * 128 + 32 * kq + i4), qv = *(const LAS f32x4*)(qn + c * 128 + 32 * kq + i4);
#pragma unroll
            for (int e = 0; e < 4; ++e) { pw += wv[e] * S[i4 + e]; pq += qv[e] * S[i4 + e]; } }
        red[((0 * 4 + kq) * 8 + c) * 128 + v] = pw; red[((1 * 4 + kq) * 8 + c) * 128 + v] = pq * sc[16 + c]; }
    __syncthreads();
    float vnew[8];
#pragma unroll
    for (int c = 0; c < 8; ++c) vnew[c] = ul[c * 128 + v] - ((red[((0 * 4 + 0) * 8 + c) * 128 + v] + red[((0 * 4 + 1) * 8 + c) * 128 + v]) + (red[((0 * 4 + 2) * 8 + c) * 128 + v] + red[((0 * 4 + 3) * 8 + c) * 128 + v]));
    { const float dec = sc[32];
#pragma unroll
      for (int i = 0; i < 32; ++i) S[i] *= dec; }
#pragma unroll
    for (int c = 0; c < 8; ++c) { const float vc = vnew[c] * sc[24 + c];
#pragma unroll
        for (int i4 = 0; i4 < 32; i4 += 4) { const f32x4 kv = *(const LAS f32x4*)(kn + c * 128 + 32 * kq + i4);
#pragma unroll
            for (int e = 0; e < 4; ++e) S[i4 + e] += kv[e] * vc; } }
    { float* so = a->out + O_SDNS + (((size_t)j * NB_S + b) * NH + h) * HD * HD + (size_t)(32 * kq) * HD + v;
#pragma unroll
      for (int i = 0; i < 32; ++i) so[(size_t)i * HD] = S[i]; }
    {
        float* Og = (float*)(a->ws + WS_R2 + R2_OS);
#pragma unroll
        for (int cc = 0; cc < 2; ++cc) { const int c = 2 * kq + cc;
            float o = (red[((1 * 4 + 0) * 8 + c) * 128 + v] + red[((1 * 4 + 1) * 8 + c) * 128 + v]) + (red[((1 * 4 + 2) * 8 + c) * 128 + v] + red[((1 * 4 + 3) * 8 + c) * 128 + v]);
#pragma unroll
            for (int jx = 0; jx < 8; ++jx) o += T8[c * 8 + jx] * vnew[jx];
            Og[(size_t)(b * DSEQ + c) * D + h * HD + v] = o; }
    }
}
__device__ __forceinline__ void dn_scan_phase(const Frame& F, KArgs a, int j) {
    if ((F.vcu & 3) == 0) dn_scan_unit(F, a, j, F.vcu >> 2);
    else { const int idx = F.vcu - (F.vcu >> 2) - 1, nw = F.G - (F.G >> 2); for (int u = idx; u < NB_S * NH; u += nw) dn_sample_unit(F, a, j, u); }
}
__device__ __forceinline__ void dn_gate_phase(const Frame& F, KArgs a, int j) {
    bf16_t* proj = (bf16_t*)(a->ws + WS_R1); const float* O = (const float*)(a->ws + WS_R1); const float* ng = a->in[12] + j * HD;
    const int gw = F.vcu * NWAVES + F.wave, NGW = F.G * NWAVES, lane = F.lane;
    const f32x2 nv = *(const f32x2*)(ng + 2 * lane);
    for (int it = gw; it < M * NH; it += NGW) {
        const int r = it >> 3, h = it & 7;
        const f32x2 o = *(const f32x2*)((r < M_P ? O + (size_t)r * OLD : (const float*)(a->ws + WS_R2 + R2_OS) + (size_t)(r - M_P) * D) + h * HD + 2 * lane);
        const float rs = rsqrtf(wave_sum(o.x * o.x + o.y * o.y) * (1.0f / HD) + RMS_EPS);
        bf16_t* zp = proj + (size_t)r * PROJW + QKV + h * HD + 2 * lane; const unsigned zw = *(const unsigned*)zp;
        *(unsigned*)zp = pk2(o.x * rs * nv.x * siluf_(bf2f(zw & 0xffffu)), o.y * rs * nv.y * siluf_(bf2f(zw >> 16)));
    }
}
__device__ __forceinline__ void sc_act_phase(const Frame& F, KArgs a, int j) {
    bf16_t* proj = (bf16_t*)(a->ws + WS_R1); const float* cw = a->in[15] + (size_t)j * 3 * D; const float* sbuf = a->in[6] + (size_t)j * NB_S * 2 * D;
    const int gw = F.vcu * NWAVES + F.wave, NGW = F.G * NWAVES, lane = F.lane;
    for (int it = gw; it < M * 2; it += NGW) {
        const int r = it >> 1, c0 = (it & 1) * 512 + 8 * lane; int b, t, L; bool smp; row_info(r, b, t, L, smp);
        float y[8];
#pragma unroll
        for (int e = 0; e < 8; ++e) y[e] = 0.f;
#pragma unroll
        for (int jj = 0; jj < 3; ++jj) { const int d = 2 - jj; float u[8];
            if (t - d >= 0) { float cc[8], hh[8]; unpack8(*(const u32x4*)(proj + (size_t)(r - d) * 3072 + 1024 + c0), cc); unpack8(*(const u32x4*)(proj + (size_t)(r - d) * 3072 + 2048 + c0), hh);
#pragma unroll
                for (int e = 0; e < 8; ++e) u[e] = cc[e] * hh[e]; }
            else if (smp) { const float* p = sbuf + ((size_t)b * 2 + (t + jj)) * D + c0;
#pragma unroll
                for (int e = 0; e < 8; ++e) u[e] = p[e]; }
            else {
#pragma unroll
                for (int e = 0; e < 8; ++e) u[e] = 0.f; }
            const float* wp = cw + (size_t)jj * D + c0;
#pragma unroll
            for (int e = 0; e < 8; ++e) y[e] += wp[e] * u[e];
            if (jj == 2 && t >= L - 2) { float* o = a->out + (smp ? O_SSC : O_PSC) + (((size_t)j * (smp ? NB_S : NB_P) + b) * 2 + (t - (L - 2))) * D + c0;
#pragma unroll
                for (int e = 0; e < 8; ++e) o[e] = u[e]; } }
        float bb[8]; bf16_t* bp = proj + (size_t)r * 3072 + c0; unpack8(*(const u32x4*)bp, bb);
#pragma unroll
        for (int e = 0; e < 8; ++e) y[e] *= bb[e];
        *(u32x4*)bp = pack8(y);
    }
}
__device__ __forceinline__ void ffn_act_phase(const Frame& F, KArgs a, int l) {
    const bf16_t* up = (const bf16_t*)(a->ws + WS_R2); bf16_t* act = (bf16_t*)(a->ws + WS_R1);
    const float* cw = a->in[18] + (size_t)l * 3 * DFF2; const float* sbuf = a->in[7] + (size_t)l * NB_S * 2 * DFF2;
    const int gw = F.vcu * NWAVES + F.wave, NGW = F.G * NWAVES, lane = F.lane;
    for (int it = gw; it < M * 6; it += NGW) {
        const int r = it / 6, c0 = (it % 6) * 512 + 8 * lane; if (c0 >= DFF) continue;
        int b, t, L; bool smp; row_info(r, b, t, L, smp);
        float yv[8], yg[8];
#pragma unroll
        for (int e = 0; e < 8; ++e) { yv[e] = 0.f; yg[e] = 0.f; }
#pragma unroll
        for (int jj = 0; jj < 3; ++jj) { const int d = 2 - jj; float uv[8], ug[8];
            if (t - d >= 0) { unpack8(*(const u32x4*)(up + (size_t)(r - d) * DFF2 + c0), uv); unpack8(*(const u32x4*)(up + (size_t)(r - d) * DFF2 + DFF + c0), ug); }
            else if (smp) { const float* p = sbuf + ((size_t)b * 2 + (t + jj)) * DFF2 + c0;
#pragma unroll
                for (int e = 0; e < 8; ++e) { uv[e] = p[e]; ug[e] = p[DFF + e]; } }
            else {
#pragma unroll
                for (int e = 0; e < 8; ++e) { uv[e] = 0.f; ug[e] = 0.f; } }
            const float* wp = cw + (size_t)jj * DFF2 + c0;
#pragma unroll
            for (int e = 0; e < 8; ++e) { yv[e] += wp[e] * uv[e]; yg[e] += wp[DFF + e] * ug[e]; }
            if (jj == 2 && t >= L - 2) { float* o = a->out + (smp ? O_SFFN : O_PFFN) + (((size_t)l * (smp ? NB_S : NB_P) + b) * 2 + (t - (L - 2))) * DFF2 + c0;
#pragma unroll
                for (int e = 0; e < 8; ++e) { o[e] = uv[e]; o[DFF + e] = ug[e]; } } }
#pragma unroll
        for (int e = 0; e < 8; ++e) yv[e] *= siluf_(yg[e]);
        *(u32x4*)(act + (size_t)r * DFF + c0) = pack8(yv);
    }
}

enum Kind { K_P0 = 0, K_PROJ, K_DN_PRE, K_DN_SCAN, K_DN_GATE, K_SC_ACT, K_WOUT, K_UP, K_ACT, K_DOWN, K_GATE };
constexpr int N_PHASES = 1 + 9 + 7 + 9 + 7;
__host__ __device__ __forceinline__ void decode_phase(int p, int& l, int& kind) {
    if (p == 0) { l = 0; kind = K_P0; return; }
    p -= 1; l = 0;
    for (;;) { const int n = (l & 1) ? 7 : 9; if (p < n) break; p -= n; ++l; }
    const unsigned long long dnk = 0xA98764321ull  , sck = 0xA987651ull  ;
    kind = (int)((((l & 1) == 0 ? dnk : sck) >> (4 * p)) & 0xFull);
}

__global__ void __launch_bounds__(NTHR, 2) mk_fwd(Args args) {
    extern __shared__ __attribute__((aligned(16))) unsigned char lds_raw[];
    Frame F; F.lds = (LAS unsigned char*)lds_raw; F.tid = threadIdx.x; F.lane = F.tid & 63; F.wave = __builtin_amdgcn_readfirstlane(F.tid >> 6);
    F.G = gridDim.x; { const int bx = blockIdx.x; F.vcu = (F.G % 8 == 0) ? (bx % 8) * (F.G / 8) + bx / 8 : bx; }
    volatile LAS unsigned* MISC = (volatile LAS unsigned*)(F.lds + MISC_OFF);
    for (int u = F.tid; u < (LDS_BYTES - LDSCTL_OFF) / 4; u += NTHR) ((LAS unsigned*)(F.lds + LDSCTL_OFF))[u] = 0u;
    __syncthreads();
    const int ph_lo = args.ph_lo, ph_hi = args.ph_hi;
    XcdBarrier bar; bar.bar = (unsigned*)(args.ws + WS_CTL) + CW_BAR; bar.x = 0; bar.st = nullptr;
    if (ph_hi - ph_lo > 1) bar = xcd_barrier_post((unsigned*)(args.ws + WS_CTL) + CW_BAR, MISC + 8);
    int redo = 0;
    for (int p = ph_lo; p < ph_hi; ++p) {
        KArgs ka = (KArgs)__builtin_amdgcn_kernarg_segment_ptr(); asm volatile("" : "+s"(ka));
        { int t_ = threadIdx.x; asm volatile("" : "+v"(t_)); F.tid = t_; F.lane = t_ & 63; F.wave = __builtin_amdgcn_readfirstlane(t_ >> 6); }
        int l, kind; decode_phase(p, l, kind);
        const int j = l >> 1; const bool dn = (l & 1) == 0;
        unsigned char* ws = ka->ws;
        switch (kind) {
        case K_P0: p0_prologue(F, ka); break;
        case K_PROJ: {
            const int N = dn ? 4352 : 3072;
            pg8::Gemm g{(const bf16_t*)(ws + ((l & 1) ? WS_X1 : WS_X0)), wl_base(ka, l) + WL_IN, M, N, D, D}; pg8::StaticOrder S; S.init(M, N, F.G, (int)blockIdx.x);
            pg8::EpiBf16 E{(bf16_t*)(ws + WS_R1), dn ? PROJW : 3072, (float*)(ws + WS_BA), dn ? 16 : -1};
            pg8::gemm_phase<pg8::EpiBf16, pg8::StaticOrder>(F.lds, F.tid, g, S, E);
        } break;
        case K_DN_PRE: dn_chunk_phase(F, ka, j); break;
        case K_DN_SCAN: dn_scan_phase(F, ka, j); break;
        case K_DN_GATE: dn_gate_phase(F, ka, j); break;
        case K_SC_ACT: sc_act_phase(F, ka, j); break;
        case K_WOUT: {
            const bf16_t* R1 = (const bf16_t*)(ws + WS_R1);
            pg8::Gemm g{dn ? R1 + QKV : R1, wl_base(ka, l) + WL_OUT, M, D, D, dn ? PROJW : 3072}; pg8::StaticOrder S; S.init(M, D, F.G, (int)blockIdx.x);
            pg8::EpiResStats E{(bf16_t*)(ws + ((l & 1) ? WS_X1 : WS_X0)), (float*)(ws + WS_ST1)};
            pg8::gemm_phase<pg8::EpiResStats, pg8::StaticOrder>(F.lds, F.tid, g, S, E);
        } break;
        case K_UP: {
            const float* vb = vec_base(ka, l);
            pg8::Gemm g{(const bf16_t*)(ws + ((l & 1) ? WS_X1 : WS_X0)), wl_base(ka, l) + WL_UP, M, DFF2, D, D}; pg8::StaticOrder S; S.init(M, DFF2, F.G, (int)blockIdx.x);
            pg8::EpiLnFold E{(bf16_t*)(ws + WS_R2), DFF2, (const float*)(ws + WS_ST1), vb, vb + DFF2};
            pg8::gemm_phase<pg8::EpiLnFold, pg8::StaticOrder>(F.lds, F.tid, g, S, E);
        } break;
        case K_ACT: {
            ffn_act_phase(F, ka, l);
            pg8::Gemm g{(const bf16_t*)(ws + WS_PB) + (size_t)l * M * DPLE, wl_base(ka, l) + WL_P, M, D, DPLE, DPLE}; pg8::StaticOrder S; S.init(M, D, F.G, (int)blockIdx.x);
            pg8::EpiBf16 E{(bf16_t*)(ws + WS_R1) + (size_t)M * DFF, D, nullptr, -1};
            pg8::gemm_phase<pg8::EpiBf16, pg8::StaticOrder>(F.lds, F.tid, g, S, E);
        } break;
        case K_DOWN: {
            pg8::Gemm g{(const bf16_t*)(ws + WS_R1), wl_base(ka, l) + WL_DOWN, M, D, DFF, DFF}; pg8::StaticOrder S; S.init(M, D, F.G, (int)blockIdx.x);
            pg8::EpiLnResStats E{(bf16_t*)(ws + ((l & 1) ? WS_X1 : WS_X0)), (const float*)(ws + WS_ST1), (float*)(ws + WS_ST2), ka->in[20] + l * D, ka->in[21] + l * D};
            pg8::gemm_phase<pg8::EpiLnResStats, pg8::StaticOrder>(F.lds, F.tid, g, S, E);
        } break;
        case K_GATE: {
            const float* vb = vec_base(ka, l);
            const bf16_t* Xc = (const bf16_t*)(ws + ((l & 1) ? WS_X1 : WS_X0));
            pg8::Gemm g{Xc, wl_base(ka, l) + WL_G, M, D, D, D}; pg8::StaticOrder S; S.init(M, D, F.G, (int)blockIdx.x);
            pg8::EpiGate E{Xc, (const bf16_t*)(ws + WS_R1) + (size_t)M * DFF, (bf16_t*)(ws + ((l & 1) ? WS_X0 : WS_X1)), l == DEPTH - 1 ? ka->out + O_Y : nullptr, (const float*)(ws + WS_ST2),
                           vb + 2 * DFF2, vb + 2 * DFF2 + D, ka->in[22] + l * D, ka->in[23] + l * D};
            pg8::gemm_phase<pg8::EpiGate, pg8::StaticOrder>(F.lds, F.tid, g, S, E);
        } break;
        default: break;
        }
        if (MK_DOUBLE_MASK) { if (((MK_DOUBLE_MASK >> kind) & 1) && !redo) { redo = 1; xcd_barrier(bar); --p; continue; } redo = 0; }
        if (p + 1 < ph_hi) xcd_barrier(bar);
    }
}

extern "C" void kernel_launch(void* const* d_in, const int* in_sizes, int n_in, void* d_out, int out_size, void* d_ws, size_t ws_size, hipStream_t stream) {
    static int grid = 0;
    if (grid == 0) {
        if (n_in != 26 || out_size != (int)O_END || ws_size < WS_END) { fprintf(stderr, "kernel_launch: unexpected shapes (n_in %d, out %d, ws %zu; need ws >= %zu)\n", n_in, out_size, ws_size, (size_t)WS_END); grid = -1; return; }
        int dev = 0, cus = 0;
        if (hipGetDevice(&dev) != hipSuccess || hipDeviceGetAttribute(&cus, hipDeviceAttributeMultiprocessorCount, dev) != hipSuccess) { grid = -1; return; }
        if (hipFuncSetAttribute((const void*)mk_fwd, hipFuncAttributeMaxDynamicSharedMemorySize, LDS_BYTES) != hipSuccess) { fprintf(stderr, "kernel_launch: hipFuncSetAttribute failed\n"); grid = -1; return; }
        int per_cu = 0; (void)hipOccupancyMaxActiveBlocksPerMultiprocessor(&per_cu, (const void*)mk_fwd, NTHR, LDS_BYTES); (void)hipGetLastError();
        grid = cus;
    }
    if (grid < 0) return;
    (void)hipMemsetAsync((char*)d_ws + WS_CTL, 0, CTL_ZERO_BYTES, stream);
    Args a{};
    for (int i = 0; i < 26; ++i) a.in[i] = (const float*)d_in[i];
    a.out = (float*)d_out; a.ws = (unsigned char*)d_ws;
#if MK_PER_PHASE_LAUNCH
    for (int p = 0; p < N_PHASES; ++p) { a.ph_lo = p; a.ph_hi = p + 1; hipLaunchKernelGGL(mk_fwd, dim3(grid), dim3(NTHR), LDS_BYTES, stream, a); }
#else
    a.ph_lo = 0; a.ph_hi = N_PHASES; hipLaunchKernelGGL(mk_fwd, dim3(grid), dim3(NTHR), LDS_BYTES, stream, a);
#endif
}
```

```cpp
#include <hip/hip_runtime.h>
#include <cstdio>
#include <cstdint>

#ifndef MK_PER_PHASE_LAUNCH
#define MK_PER_PHASE_LAUNCH 0
#endif

#ifndef MK_SUB_REP
#define MK_SUB_REP 1
#endif
#ifndef MK_CONV_REP
#define MK_CONV_REP 1
#endif
#ifndef MK_DOUBLE_MASK
#define MK_DOUBLE_MASK 0
#endif
#define LAS __attribute__((address_space(3)))
#define GAS __attribute__((address_space(1)))
typedef unsigned short bf16_t;
typedef short bf16x8 __attribute__((ext_vector_type(8)));
typedef float f32x4 __attribute__((ext_vector_type(4)));
typedef float f32x2 __attribute__((ext_vector_type(2)));
typedef unsigned u32x4 __attribute__((ext_vector_type(4)));
typedef unsigned u32x2 __attribute__((ext_vector_type(2)));

constexpr int D = 1024, M_P = 16384, M_S = 1024, M = M_P + M_S, SEQ = 2048, DSEQ = 8, NB_P = 8, NB_S = 128;
constexpr int NH = 8, HD = 128, QKV = 3072, AIN = 4112, PROJW = 4096, DFF = 2816, DFF2 = 5632, DPLE = 256, DEPTH = 4;
constexpr float ALPHA = 1.6817928305074290f;
constexpr float LN_EPS = 1e-5f, RMS_EPS = 1e-6f, L2_EPS = 1e-6f;
constexpr float QSCALE = 0.08838834764831845f;

constexpr size_t O_Y = 0, O_PDNC = 17825792, O_PDNS = O_PDNC + 147456, O_PSC = O_PDNS + 2097152, O_PFFN = O_PSC + 32768,
                 O_SDNC = O_PFFN + 360448, O_SDNS = O_SDNC + 2359296, O_SSC = O_SDNS + 33554432, O_SFFN = O_SSC + 524288, O_END = O_SFFN + 5767168;

constexpr size_t WL_IN = 0, WL_OUT = WL_IN + (size_t)4352 * 1024, WL_UP = WL_OUT + (size_t)1024 * 1024, WL_DOWN = WL_UP + (size_t)DFF2 * 1024,
                 WL_G = WL_DOWN + (size_t)1024 * DFF, WL_P = WL_G + (size_t)1024 * 1024, WL_SIZE = WL_P + (size_t)1024 * 256;
constexpr size_t MiB = 1u << 20;
constexpr size_t WS_CTL = 0, CTL_ZERO_BYTES = 1 * MiB;
constexpr size_t WS_VEC = 1 * MiB;
constexpr size_t VEC_L = 2 * DFF2 + 2 * 1024;
constexpr size_t WS_BA = 2 * MiB;
constexpr size_t WS_GATES = WS_BA + (size_t)M * 16 * 4 + 65536;
constexpr size_t WS_ST1 = 5 * MiB, WS_ST2 = 8 * MiB;
constexpr size_t WS_W23 = 11 * MiB;
constexpr size_t WS_X0 = WS_W23 + 2 * WL_SIZE * 2;
constexpr size_t WS_X1 = WS_X0 + (size_t)M * D * 2;
constexpr size_t WS_PB = WS_X1 + (size_t)M * D * 2;
constexpr size_t WS_R1 = WS_PB + (size_t)4 * M * DPLE * 2;
constexpr size_t WS_R2 = WS_R1 + (size_t)M * PROJW * 2;
constexpr size_t WS_END = WS_R2 + (size_t)M * DFF2 * 2;
static_assert(WS_END <= (size_t)520 * MiB, "workspace budget");
constexpr size_t R2_UPS = 0, R2_HB = (size_t)12 * MiB, R2_HF = (size_t)16 * MiB;
constexpr int XA_OFF = 132096;
constexpr int CU_WF = 0, CU_QF = 16384, CU_KF = 32768, CU_AF = 49152, CU_U = 55296, CU_BYTES = 88064, CU_LDS = 55296, N_CU = NB_P * NH * 32;
constexpr size_t R2_DEC = (size_t)N_CU * CU_BYTES;
static_assert(R2_DEC + N_CU * 4 <= (size_t)M * DFF2 * 2, "chunk intermediates fit in R2");
constexpr int OLD = 2048;
constexpr size_t R2_OS = R2_DEC + 65536;
static_assert(R2_OS + (size_t)M_S * D * 4 <= (size_t)M * DFF2 * 2, "sample o fits in R2");

__device__ __forceinline__ float bf2f(unsigned b) { return __uint_as_float(b << 16); }
__device__ __forceinline__ unsigned f2bf(float f) { unsigned u = __float_as_uint(f); return (u + 0x7fffu + ((u >> 16) & 1u)) >> 16; }
__device__ __forceinline__ unsigned pk2(float lo, float hi) { return f2bf(lo) | (f2bf(hi) << 16); }
typedef __bf16 bf16x2_t __attribute__((ext_vector_type(2)));
__device__ __forceinline__ unsigned cvtpk(float lo, float hi) { f32x2 v = {lo, hi}; bf16x2_t b = __builtin_convertvector(v, bf16x2_t); return __builtin_bit_cast(unsigned, b); }
__device__ __forceinline__ int crow(int reg, int hh) { return (reg & 3) + 8 * (reg >> 2) + 4 * hh; }
typedef float f32x16 __attribute__((ext_vector_type(16)));
__device__ __forceinline__ float sigmoidf_(float x) { return __builtin_amdgcn_rcpf(1.0f + __expf(-x)); }
__device__ __forceinline__ float siluf_(float x) { return x * __builtin_amdgcn_rcpf(1.0f + __expf(-x)); }
__device__ __forceinline__ void unpack8(const u32x4 w, float (&f)[8]) {
    f[0] = __uint_as_float(w.x << 16); f[1] = __uint_as_float(w.x & 0xffff0000u); f[2] = __uint_as_float(w.y << 16); f[3] = __uint_as_float(w.y & 0xffff0000u);
    f[4] = __uint_as_float(w.z << 16); f[5] = __uint_as_float(w.z & 0xffff0000u); f[6] = __uint_as_float(w.w << 16); f[7] = __uint_as_float(w.w & 0xffff0000u);
}
__device__ __forceinline__ u32x4 pack8(const float (&f)[8]) { u32x4 w; w.x = pk2(f[0], f[1]); w.y = pk2(f[2], f[3]); w.z = pk2(f[4], f[5]); w.w = pk2(f[6], f[7]); return w; }
__device__ __forceinline__ float wave_sum(float v) {
#pragma unroll
    for (int o = 1; o < 64; o <<= 1) v += __shfl_xor(v, o);
    return v;
}
__device__ __forceinline__ void row_info(int r, int& b, int& t, int& L, bool& smp) {
    if (r < M_P) { b = r >> 11; t = r & 2047; L = SEQ; smp = false; } else { const int q = r - M_P; b = q >> 3; t = q & 7; L = DSEQ; smp = true; }
}

namespace pg8 {
constexpr int BM = 256, BK = 64, HALF = 128, HTB = HALF * BK * 2, STAGE_BYTES = 8 * HTB, NXCD = 8, WGM = 8;
__host__ __device__ __forceinline__ int lds_byte(int r, int c) { const int st = (r >> 4) * 2 + (c >> 5), rr = r & 15, cc = c & 31, ob = rr * 64 + cc * 2; return st * 1024 + (ob ^ (((ob >> 9) & 1) << 5)); }
__host__ __device__ __forceinline__ void stage_rc(int b, int& R, int& C) { const int st = b / 1024, sb = b % 1024, swz = sb ^ (((sb >> 9) & 1) << 5); R = (st >> 1) * 16 + swz / 64; C = (st & 1) * 32 + (swz % 64) / 2; }
__host__ __device__ __forceinline__ int perm32(int rho) { const int n = rho >> 4, i = rho & 15; return 8 * (i >> 2) + 4 * n + (i & 3); }

struct Unit { int pm, pn; };
struct Gemm { const bf16_t* A; const bf16_t* Bt; int M, N, K, lda; };

struct StaticOrder {
    int nM, nN, nwg, G, c;
    __host__ __device__ void init(int M_, int N_, int G_, int c_) { nM = M_ / BM; nN = N_ / BM; nwg = nM * nN; G = G_; c = c_; }
    __host__ __device__ bool next(int i, Unit& u) const {
        const long L = (long)i * G + c; if (L >= nwg) return false;
        int wgid = (int)L; { const int q = nwg / NXCD, r = nwg % NXCD, xcd = wgid % NXCD, off = wgid / NXCD; wgid = (xcd < r ? xcd * (q + 1) : r * (q + 1) + (xcd - r) * q) + off; }
        const int nig = WGM * nN, gid = wgid / nig, fm = gid * WGM, gsz = (nM - fm) < WGM ? (nM - fm) : WGM;
        u.pm = fm + ((wgid % nig) % gsz); u.pn = (wgid % nig) / gsz; return true;
    }
    __device__ __forceinline__ void a_ready(const Unit&) const {}
    __device__ __forceinline__ void done(const Unit&) const {}
};

typedef f32x4 Acc[2][2][4][2];

__device__ __forceinline__ void row_stats(const float* st  , int row, int fq, float& mu, float& rstd) {
    const f32x4* p = (const f32x4*)(st + (size_t)row * 32 + 8 * fq);
    const f32x4 a = p[0], b = p[1];
    float s = (a.x + a.z) + (b.x + b.z), q = (a.y + a.w) + (b.y + b.w);
    s += __shfl_xor(s, 16); s += __shfl_xor(s, 32); q += __shfl_xor(q, 16); q += __shfl_xor(q, 32);
    mu = s * (1.0f / 1024.0f); const float var = fmaxf(q * (1.0f / 1024.0f) - mu * mu, 0.f); rstd = rsqrtf(var + LN_EPS);
}

__device__ __forceinline__ void row_stats8(const float* st, int row, int cg, float& mu, float& rstd) {
    const f32x4 a = *(const f32x4*)(st + (size_t)row * 32 + 4 * cg);
    float s = a.x + a.z, q = a.y + a.w;
    s += __shfl_xor(s, 1); s += __shfl_xor(s, 2); s += __shfl_xor(s, 4); q += __shfl_xor(q, 1); q += __shfl_xor(q, 2); q += __shfl_xor(q, 4);
    mu = s * (1.0f / 1024.0f); const float var = fmaxf(q * (1.0f / 1024.0f) - mu * mu, 0.f); rstd = rsqrtf(var + LN_EPS);
}
struct EpiBf16 {
    static constexpr bool PERM = true, PERMA = false;
    bf16_t* O; int ldc; float* ba; int ba_pn;
    __device__ __forceinline__ void small(int row, int col, const float (&v)[8], int slot, int cg) const { *(u32x4*)(O + (size_t)row * ldc + col) = pack8(v); }
    __device__ __forceinline__ void operator()(const Acc& acc, const Unit& u, int wr, int wc, int fr, int fq) const {
        const int row0 = u.pm * BM + wr * 64 + fr;
        if (u.pn == ba_pn) {
            if (wc == 0 && fq < 2) {
#pragma unroll
                for (int ai = 0; ai < 2; ++ai)
#pragma unroll
                    for (int m = 0; m < 4; ++m) { float* p = ba + (size_t)(row0 + ai * HALF + m * 16) * 16 + 8 * fq; *(f32x4*)p = acc[ai][0][m][0]; *(f32x4*)(p + 4) = acc[ai][0][m][1]; }
            }
            return;
        }
        const int col0 = u.pn * BM + wc * 32 + 8 * fq;
#pragma unroll
        for (int ai = 0; ai < 2; ++ai)
#pragma unroll
            for (int m = 0; m < 4; ++m) { bf16_t* rowp = O + (size_t)(row0 + ai * HALF + m * 16) * ldc + col0;
#pragma unroll
                for (int bj = 0; bj < 2; ++bj) { const f32x4 v0 = acc[ai][bj][m][0], v1 = acc[ai][bj][m][1];
                    u32x4 w; w.x = pk2(v0[0], v0[1]); w.y = pk2(v0[2], v0[3]); w.z = pk2(v1[0], v1[1]); w.w = pk2(v1[2], v1[3]);
                    *(u32x4*)(rowp + bj * HALF) = w; } }
    }
};
struct EpiResStats {
    static constexpr bool PERM = true, PERMA = false;
    bf16_t* X; float* st;
    __device__ __forceinline__ void small(int row, int col, const float (&v)[8], int slot, int cg) const {
        bf16_t* p = X + (size_t)row * D + col; float x[8]; unpack8(*(const u32x4*)p, x); float s = 0.f, q = 0.f;
#pragma unroll
        for (int e = 0; e < 8; ++e) { x[e] = ALPHA * x[e] + v[e]; s += x[e]; q += x[e] * x[e]; }
        *(u32x4*)p = pack8(x);
        s += __shfl_xor(s, 1); s += __shfl_xor(s, 2); s += __shfl_xor(s, 4); q += __shfl_xor(q, 1); q += __shfl_xor(q, 2); q += __shfl_xor(q, 4);
        if (cg == 0) *(f32x2*)(st + ((size_t)row * 16 + slot) * 2) = (f32x2){s, q};
    }
    __device__ __forceinline__ void operator()(const Acc& acc, const Unit& u, int wr, int wc, int fr, int fq) const {
        const int row0 = u.pm * BM + wr * 64 + fr, col0 = u.pn * BM + wc * 32 + 8 * fq;
#pragma unroll
        for (int ai = 0; ai < 2; ++ai)
#pragma unroll
            for (int m = 0; m < 4; ++m) { const int row = row0 + ai * HALF + m * 16; bf16_t* rowp = X + (size_t)row * D + col0; float s = 0.f, q = 0.f;
#pragma unroll
                for (int bj = 0; bj < 2; ++bj) { float x[8]; unpack8(*(const u32x4*)(rowp + bj * HALF), x); const f32x4 v0 = acc[ai][bj][m][0], v1 = acc[ai][bj][m][1];
#pragma unroll
                    for (int e = 0; e < 4; ++e) { x[e] = ALPHA * x[e] + v0[e]; x[4 + e] = ALPHA * x[4 + e] + v1[e]; }
#pragma unroll
                    for (int e = 0; e < 8; ++e) { s += x[e]; q += x[e] * x[e]; }
                    *(u32x4*)(rowp + bj * HALF) = pack8(x); }
                s += __shfl_xor(s, 16); s += __shfl_xor(s, 32); q += __shfl_xor(q, 16); q += __shfl_xor(q, 32);
                if (fq == 0) *(f32x2*)(st + ((size_t)row * 16 + u.pn * 4 + wc) * 2) = (f32x2){s, q}; }
    }
};
struct EpiLnResStats {
    static constexpr bool PERM = true, PERMA = false;
    bf16_t* X; const float* st_in; float* st_out; const float* g; const float* b;
    __device__ __forceinline__ void small(int row, int col, const float (&v)[8], int slot, int cg) const {
        float mu, rs; row_stats8(st_in, row, cg, mu, rs);
        bf16_t* p = X + (size_t)row * D + col; float x[8]; unpack8(*(const u32x4*)p, x); float s = 0.f, q = 0.f;
        const f32x4 g0 = *(const f32x4*)(g + col), g1 = *(const f32x4*)(g + col + 4), b0 = *(const f32x4*)(b + col), b1 = *(const f32x4*)(b + col + 4);
#pragma unroll
        for (int e = 0; e < 4; ++e) { x[e] = ALPHA * ((x[e] - mu) * rs * g0[e] + b0[e]) + v[e]; x[4 + e] = ALPHA * ((x[4 + e] - mu) * rs * g1[e] + b1[e]) + v[4 + e]; }
#pragma unroll
        for (int e = 0; e < 8; ++e) { s += x[e]; q += x[e] * x[e]; }
        *(u32x4*)p = pack8(x);
        s += __shfl_xor(s, 1); s += __shfl_xor(s, 2); s += __shfl_xor(s, 4); q += __shfl_xor(q, 1); q += __shfl_xor(q, 2); q += __shfl_xor(q, 4);
        if (cg == 0) *(f32x2*)(st_out + ((size_t)row * 16 + slot) * 2) = (f32x2){s, q};
    }
    __device__ __forceinline__ void operator()(const Acc& acc, const Unit& u, int wr, int wc, int fr, int fq) const {
        const int row0 = u.pm * BM + wr * 64 + fr, col0 = u.pn * BM + wc * 32 + 8 * fq;
        f32x4 gv[2][2], bv[2][2];
#pragma unroll
        for (int bj = 0; bj < 2; ++bj)
#pragma unroll
            for (int n = 0; n < 2; ++n) { gv[bj][n] = *(const f32x4*)(g + col0 + bj * HALF + 4 * n); bv[bj][n] = *(const f32x4*)(b + col0 + bj * HALF + 4 * n); }
#pragma unroll
        for (int ai = 0; ai < 2; ++ai)
#pragma unroll
            for (int m = 0; m < 4; ++m) { const int row = row0 + ai * HALF + m * 16; bf16_t* rowp = X + (size_t)row * D + col0; float s = 0.f, q = 0.f;
                float mu, rs; row_stats(st_in, row, fq, mu, rs);
#pragma unroll
                for (int bj = 0; bj < 2; ++bj) { float x[8]; unpack8(*(const u32x4*)(rowp + bj * HALF), x); const f32x4 v0 = acc[ai][bj][m][0], v1 = acc[ai][bj][m][1];
#pragma unroll
                    for (int e = 0; e < 4; ++e) { x[e] = ALPHA * ((x[e] - mu) * rs * gv[bj][0][e] + bv[bj][0][e]) + v0[e]; x[4 + e] = ALPHA * ((x[4 + e] - mu) * rs * gv[bj][1][e] + bv[bj][1][e]) + v1[e]; }
#pragma unroll
                    for (int e = 0; e < 8; ++e) { s += x[e]; q += x[e] * x[e]; }
                    *(u32x4*)(rowp + bj * HALF) = pack8(x); }
                s += __shfl_xor(s, 16); s += __shfl_xor(s, 32); q += __shfl_xor(q, 16); q += __shfl_xor(q, 32);
                if (fq == 0) *(f32x2*)(st_out + ((size_t)row * 16 + u.pn * 4 + wc) * 2) = (f32x2){s, q}; }
    }
};
struct EpiUpAct {
    static constexpr bool PERM = true, PERMA = true;
    bf16_t* ACT; bf16_t* UPS; float* HB; float* HF; const float* st; const float* c1; const float* c2; const float* cw; float* outp; LAS float* XA;
    __device__ __forceinline__ void operator()(Acc& acc, const Unit& u, int wr, int wc, int fr, int fq) const {
        const int pm = u.pm, pn = u.pn, colb = wc * 32 + 8 * fq, rowb = pm * BM + wr * 64 + 4 * fr;
        float mu[2][4], rs[2][4];
#pragma unroll
        for (int ai = 0; ai < 2; ++ai)
#pragma unroll
            for (int m = 0; m < 4; ++m) row_stats(st, rowb + ai * HALF + m, fq, mu[ai][m], rs[ai][m]);
#pragma unroll
        for (int bj = 0; bj < 2; ++bj)
#pragma unroll
            for (int n = 0; n < 2; ++n) { const int q = pn * BM + bj * HALF + colb + 4 * n; const f32x4 c1v = *(const f32x4*)(c1 + q), c2v = *(const f32x4*)(c2 + q);
#pragma unroll
                for (int ai = 0; ai < 2; ++ai)
#pragma unroll
                    for (int m = 0; m < 4; ++m) acc[ai][bj][m][n] = (acc[ai][bj][m][n] - mu[ai][m] * c1v) * rs[ai][m] + c2v; }
        if (pm >= M_P / BM) {
#pragma unroll
            for (int ai = 0; ai < 2; ++ai)
#pragma unroll
                for (int m = 0; m < 4; ++m) { bf16_t* rowp = UPS + (size_t)(rowb + ai * HALF + m - M_P) * DFF2 + pn * BM + colb;
#pragma unroll
                    for (int bj = 0; bj < 2; ++bj) { const f32x4 v0 = acc[ai][bj][m][0], v1 = acc[ai][bj][m][1];
                        u32x4 w; w.x = cvtpk(v0[0], v0[1]); w.y = cvtpk(v0[2], v0[3]); w.z = cvtpk(v1[0], v1[1]); w.w = cvtpk(v1[2], v1[3]); *(u32x4*)(rowp + bj * HALF) = w; } }
            return;
        }
        if (fr == 15) {
#pragma unroll
            for (int ai = 0; ai < 2; ++ai)
#pragma unroll
                for (int bj = 0; bj < 2; ++bj)
#pragma unroll
                    for (int n = 0; n < 2; ++n) { LAS float* x = XA + ((ai * 2 + wr) * 2) * 256 + bj * HALF + colb + 4 * n; *(LAS f32x4*)x = acc[ai][bj][2][n]; *(LAS f32x4*)(x + 256) = acc[ai][bj][3][n]; }
            if (wr == 1) {
#pragma unroll
                for (int bj = 0; bj < 2; ++bj)
#pragma unroll
                    for (int n = 0; n < 2; ++n)
#pragma unroll
                        for (int rr = 0; rr < 2; ++rr) { *(f32x4*)(HB + ((size_t)pm * 2 + rr) * DFF2 + pn * BM + bj * HALF + colb + 4 * n) = acc[1][bj][2 + rr][n];
                            if ((pm & 7) == 7) *(f32x4*)(outp + ((size_t)(pm >> 3) * 2 + rr) * DFF2 + bj * DFF + pn * HALF + colb + 4 * n) = acc[1][bj][2 + rr][n]; }
            }
        }
        if (fr == 0 && wr == 0 && (pm & 7) != 0) {
#pragma unroll
            for (int bj = 0; bj < 2; ++bj)
#pragma unroll
                for (int n = 0; n < 2; ++n)
#pragma unroll
                    for (int rr = 0; rr < 2; ++rr) *(f32x4*)(HF + ((size_t)pm * 2 + rr) * DFF2 + pn * BM + bj * HALF + colb + 4 * n) = acc[0][bj][rr][n];
        }
        asm volatile("s_waitcnt lgkmcnt(0)" ::: "memory"); __builtin_amdgcn_s_barrier(); asm volatile("" ::: "memory");
#pragma unroll
        for (int ai = 0; ai < 2; ++ai) {
            const int blk = ai * 2 + wr;
#pragma unroll
            for (int n = 0; n < 2; ++n) {
                const int ch = pn * HALF + colb + 4 * n;
                float hc[2][4][4];
#pragma unroll
                for (int bj = 0; bj < 2; ++bj) {
                    const f32x4 w0 = *(const f32x4*)(cw + bj * DFF + ch), w1 = *(const f32x4*)(cw + DFF2 + bj * DFF + ch), w2 = *(const f32x4*)(cw + 2 * DFF2 + bj * DFF + ch);
                    f32x4 hm1 = {0.f, 0.f, 0.f, 0.f}, hm2 = {0.f, 0.f, 0.f, 0.f};
                    if (blk > 0) { const LAS float* x = XA + ((blk - 1) * 2) * 256 + bj * HALF + colb + 4 * n; hm2 = *(const LAS f32x4*)x; hm1 = *(const LAS f32x4*)(x + 256); }
#pragma unroll
                    for (int e = 0; e < 4; ++e) {
                        const float x0 = acc[ai][bj][0][n][e], x1 = acc[ai][bj][1][n][e], x2 = acc[ai][bj][2][n][e], x3 = acc[ai][bj][3][n][e];
                        const float s3 = __int_as_float(__builtin_amdgcn_update_dpp(__float_as_int(hm1[e]), __float_as_int(x3), 0x111, 0xF, 0xF, false));
                        const float s2 = __int_as_float(__builtin_amdgcn_update_dpp(__float_as_int(hm2[e]), __float_as_int(x2), 0x111, 0xF, 0xF, false));
                        hc[bj][0][e] = w2[e] * x0 + w1[e] * s3 + w0[e] * s2;
                        hc[bj][1][e] = w2[e] * x1 + w1[e] * x0 + w0[e] * s3;
                        hc[bj][2][e] = w2[e] * x2 + w1[e] * x1 + w0[e] * x0;
                        hc[bj][3][e] = w2[e] * x3 + w1[e] * x2 + w0[e] * x1;
                    }
                }
#pragma unroll
                for (int m = 0; m < 4; ++m) { u32x2 w; w.x = cvtpk(hc[0][m][0] * siluf_(hc[1][m][0]), hc[0][m][1] * siluf_(hc[1][m][1])); w.y = cvtpk(hc[0][m][2] * siluf_(hc[1][m][2]), hc[0][m][3] * siluf_(hc[1][m][3]));
                    *(u32x2*)(ACT + (size_t)(rowb + ai * HALF + m) * DFF + ch) = w; }
            }
        }
    }
};
struct EpiGate {
    static constexpr bool PERM = true, PERMA = false;
    const bf16_t* H; const bf16_t* PP; bf16_t* XO; float* Y; const float* st; const float* c1; const float* c2; const float* g; const float* b;
    __device__ __forceinline__ void small(int row, int col, const float (&v)[8], int slot, int cg) const {
        float mu, rs; row_stats8(st, row, cg, mu, rs); const size_t off = (size_t)row * D + col;
        float h[8], pp[8], o[8]; unpack8(*(const u32x4*)(H + off), h); unpack8(*(const u32x4*)(PP + off), pp);
#pragma unroll
        for (int n = 0; n < 2; ++n) { const int cc = col + 4 * n; const f32x4 c1v = *(const f32x4*)(c1 + cc), c2v = *(const f32x4*)(c2 + cc), gv = *(const f32x4*)(g + cc), bv = *(const f32x4*)(b + cc);
#pragma unroll
            for (int e = 0; e < 4; ++e) { const float gate = (v[4 * n + e] - mu * c1v[e]) * rs + c2v[e]; const float x2 = (h[4 * n + e] - mu) * rs * gv[e] + bv[e]; o[4 * n + e] = x2 + pp[4 * n + e] * sigmoidf_(gate); } }
        *(u32x4*)(XO + off) = pack8(o);
        if (Y) { *(f32x4*)(Y + off) = (f32x4){o[0], o[1], o[2], o[3]}; *(f32x4*)(Y + off + 4) = (f32x4){o[4], o[5], o[6], o[7]}; }
    }
    __device__ __forceinline__ void operator()(const Acc& acc, const Unit& u, int wr, int wc, int fr, int fq) const {
        const int row0 = u.pm * BM + wr * 64 + fr, col0 = u.pn * BM + wc * 32 + 8 * fq;
#pragma unroll
        for (int ai = 0; ai < 2; ++ai)
#pragma unroll
            for (int m = 0; m < 4; ++m) { const int row = row0 + ai * HALF + m * 16; const size_t off = (size_t)row * D + col0;
                float mu, rs; row_stats(st, row, fq, mu, rs);
#pragma unroll
                for (int bj = 0; bj < 2; ++bj) { float h[8], pp[8], o[8]; unpack8(*(const u32x4*)(H + off + bj * HALF), h); unpack8(*(const u32x4*)(PP + off + bj * HALF), pp);
#pragma unroll
                    for (int n = 0; n < 2; ++n) { const int cc = col0 + bj * HALF + 4 * n; const f32x4 c1v = *(const f32x4*)(c1 + cc), c2v = *(const f32x4*)(c2 + cc), gv = *(const f32x4*)(g + cc), bv = *(const f32x4*)(b + cc);
#pragma unroll
                        for (int e = 0; e < 4; ++e) { const float gate = (acc[ai][bj][m][n][e] - mu * c1v[e]) * rs + c2v[e]; const float x2 = (h[4 * n + e] - mu) * rs * gv[e] + bv[e];
                            o[4 * n + e] = x2 + pp[4 * n + e] * sigmoidf_(gate); } }
                    *(u32x4*)(XO + off + bj * HALF) = pack8(o);
                    if (Y) { *(f32x4*)(Y + off + bj * HALF) = (f32x4){o[0], o[1], o[2], o[3]}; *(f32x4*)(Y + off + bj * HALF + 4) = (f32x4){o[4], o[5], o[6], o[7]}; } } }
    }
};

template <class Epi, class Sched, bool ALIGN_EPI = true>
__device__ __forceinline__ void gemm_phase(LAS unsigned char* lds, const int tid, const Gemm g, const Sched& S, const Epi& E) {
    const int wid = __builtin_amdgcn_readfirstlane(tid >> 6), lane = tid & 63, wr = wid >> 2, wc = wid & 3, fr = lane & 15, fq = lane >> 4;
    const int K = g.K, nt = K / BK, lda = g.lda;
    unsigned voffA[2], voffB[2];
#pragma unroll
    for (int i = 0; i < 2; ++i) { int R, C; stage_rc(tid * 16 + i * 8192, R, C); const int Rb = Epi::PERM ? ((R & ~31) + perm32(R & 31)) : R;
        const int Ra = Epi::PERMA ? ((R & ~63) + 4 * (R & 15) + ((R >> 4) & 3)) : R;
        voffA[i] = (unsigned)(Ra * lda + C) * 2u; voffB[i] = (unsigned)(Rb * K + C) * 2u; }
    const size_t kstep = (size_t)(BK * 2);
    const size_t hstepA = (size_t)HALF * lda * 2, hstepB = (size_t)HALF * K * 2;
    const size_t tstepA = 2 * hstepA, tstepB = 2 * hstepB;
    const unsigned ldsw = (unsigned)wid * 1024u;
    const int aoff = lds_byte(wr * 64 + fr, fq * 8), boff = lds_byte(wc * 32 + fr, fq * 8);
#define PG8_SA(b, h) (((b) * 2 + (h)) * HTB)
#define PG8_SB(b, h) ((4 + (b) * 2 + (h)) * HTB)
#define PG8_STAGE(bufoff, gbase, voff) do { _Pragma("unroll") for (int _i = 0; _i < 2; ++_i) \
        __builtin_amdgcn_global_load_lds((const unsigned*)((const char*)(gbase) + (voff)[_i]), (LAS unsigned*)(lds + (bufoff) + ldsw + _i * 8192), 16, 0, 0); } while (0)
#define PG8_LDA(dst, b, h) do { _Pragma("unroll") for (int m = 0; m < 4; ++m) _Pragma("unroll") for (int k = 0; k < 2; ++k) dst[m][k] = *(const LAS bf16x8*)(lds + PG8_SA(b, h) + aoff + m * 2048 + k * 1024); } while (0)
#define PG8_LDB(dst, b, h) do { _Pragma("unroll") for (int n = 0; n < 2; ++n) _Pragma("unroll") for (int k = 0; k < 2; ++k) dst[n][k] = *(const LAS bf16x8*)(lds + PG8_SB(b, h) + boff + n * 2048 + k * 1024); } while (0)
#define PG8_MMA(ai, bj, At, Bt) do { __builtin_amdgcn_s_setprio(1); _Pragma("unroll") for (int m = 0; m < 4; ++m) _Pragma("unroll") for (int n = 0; n < 2; ++n) _Pragma("unroll") for (int k = 0; k < 2; ++k) \
        acc[ai][bj][m][n] = __builtin_amdgcn_mfma_f32_16x16x32_bf16(Bt[n][k], At[m][k], acc[ai][bj][m][n], 0, 0, 0); __builtin_amdgcn_s_setprio(0); } while (0)
#define PG8_WAIT_V(n) asm volatile("s_waitcnt vmcnt(" #n ")" ::: "memory")
#define PG8_WAIT_L(n) asm volatile("s_waitcnt lgkmcnt(" #n ")" ::: "memory")
#define PG8_BAR __builtin_amdgcn_s_barrier()
#define PG8_SCHED __builtin_amdgcn_sched_barrier(0)
    Unit cur, nxt; int ui = 0;
    if (!S.next(0, cur)) return;
    f32x4 acc[2][2][4][2];
#pragma unroll
    for (int a = 0; a < 2; ++a)
#pragma unroll
        for (int b = 0; b < 2; ++b)
#pragma unroll
            for (int m = 0; m < 4; ++m)
#pragma unroll
                for (int n = 0; n < 2; ++n) acc[a][b][m][n] = (f32x4){0.f, 0.f, 0.f, 0.f};
    bf16x8 At[4][2], B0[2][2], B1[2][2];
    const char* cA = (const char*)g.A + (size_t)cur.pm * tstepA; const char* cB = (const char*)g.Bt + (size_t)cur.pn * tstepB;
    S.a_ready(cur);
    PG8_STAGE(PG8_SB(0, 0), cB, voffB); PG8_STAGE(PG8_SB(0, 1), cB + hstepB, voffB); PG8_STAGE(PG8_SA(0, 0), cA, voffA); PG8_STAGE(PG8_SA(0, 1), cA + hstepA, voffA);
    if (wr == 1) PG8_BAR;
    PG8_WAIT_V(2); PG8_BAR;
    PG8_STAGE(PG8_SB(1, 0), cB + kstep, voffB); PG8_STAGE(PG8_SA(1, 0), cA + kstep, voffA); PG8_STAGE(PG8_SB(1, 1), cB + hstepB + kstep, voffB);
    PG8_WAIT_V(6); PG8_BAR;
    for (;;) {
        const bool has_next = S.next(ui + 1, nxt);
        const char* nA = has_next ? (const char*)g.A + (size_t)nxt.pm * tstepA : cA; const char* nB = has_next ? (const char*)g.Bt + (size_t)nxt.pn * tstepB : cB;
        for (int t = 0; t < nt; t += 2) {
            const bool last = (t == nt - 2);
            const char* a1 = cA + (size_t)(t + 1) * kstep;
            const char* a2 = last ? nA : cA + (size_t)(t + 2) * kstep; const char* b2 = last ? nB : cB + (size_t)(t + 2) * kstep;
            const char* a3 = a2 + kstep; const char* b3 = b2 + kstep;
            if (last && has_next) S.a_ready(nxt);
            PG8_LDB(B0, 0, 0); PG8_LDB(B1, 0, 1); PG8_SCHED; PG8_LDA(At, 0, 0); PG8_STAGE(PG8_SA(1, 1), a1 + hstepA, voffA);
            PG8_WAIT_V(8); PG8_WAIT_L(0); PG8_BAR; PG8_MMA(0, 0, At, B0); PG8_MMA(0, 1, At, B1); PG8_BAR; PG8_SCHED;
            PG8_LDA(At, 0, 1); PG8_STAGE(PG8_SB(0, 0), b2, voffB); PG8_STAGE(PG8_SB(0, 1), b2 + hstepB, voffB); PG8_STAGE(PG8_SA(0, 0), a2, voffA);
            PG8_WAIT_V(8); PG8_WAIT_L(0); PG8_BAR; PG8_MMA(1, 0, At, B0); PG8_MMA(1, 1, At, B1); PG8_BAR; PG8_SCHED;
            PG8_LDB(B0, 1, 0); PG8_LDB(B1, 1, 1); PG8_SCHED; PG8_LDA(At, 1, 0); PG8_STAGE(PG8_SA(0, 1), a2 + hstepA, voffA);
            PG8_WAIT_V(8); PG8_WAIT_L(0); PG8_BAR; PG8_MMA(0, 0, At, B0); PG8_MMA(0, 1, At, B1); PG8_BAR; PG8_SCHED;
            PG8_LDA(At, 1, 1); PG8_STAGE(PG8_SB(1, 0), b3, voffB); PG8_STAGE(PG8_SB(1, 1), b3 + hstepB, voffB); PG8_STAGE(PG8_SA(1, 0), a3, voffA);
            PG8_WAIT_V(8); PG8_WAIT_L(0); PG8_BAR; PG8_MMA(1, 0, At, B0); PG8_MMA(1, 1, At, B1); PG8_BAR; PG8_SCHED;
        }
        if constexpr (ALIGN_EPI) { if (wr == 0) PG8_BAR; }
        E(acc, cur, wr, wc, fr, fq); S.done(cur);
        if (!has_next) break;
#pragma unroll
        for (int a = 0; a < 2; ++a)
#pragma unroll
            for (int b = 0; b < 2; ++b)
#pragma unroll
                for (int m = 0; m < 4; ++m)
#pragma unroll
                    for (int n = 0; n < 2; ++n) acc[a][b][m][n] = (f32x4){0.f, 0.f, 0.f, 0.f};
        cur = nxt; cA = nA; cB = nB; ++ui;
        if constexpr (ALIGN_EPI) { if (wr == 1) PG8_BAR; }
    }
    PG8_WAIT_V(0);
    if constexpr (!ALIGN_EPI) { if (wr == 0) PG8_BAR; }
    PG8_BAR;
#undef PG8_SA
#undef PG8_SB
#undef PG8_STAGE
#undef PG8_LDA
#undef PG8_LDB
#undef PG8_MMA
#undef PG8_WAIT_V
#undef PG8_WAIT_L
#undef PG8_BAR
#undef PG8_SCHED
}

template <class Epi>
__device__ __forceinline__ void small_gemm(LAS unsigned char* lds, const int tid, const int vcu, const int G, const bf16_t* A, int lda, const bf16_t* Bt, int K, int N, const Epi& E) {
    const int w = __builtin_amdgcn_readfirstlane(tid >> 6), lane = tid & 63, fr = lane & 15, fq = lane >> 4;
    const int ksl = K >> 3, nks = ksl >> 5, nU = 16 * (N >> 6);
    for (int u = vcu; u < nU; u += G) {
        const int rb = u & 15, cb = u >> 4, row0 = M_P + rb * 64, col0 = cb * 64;
        const bf16_t* ap = A + (size_t)(row0 + fr) * lda + w * ksl + 8 * fq;
        const bf16_t* bp = Bt + (size_t)(col0 + 8 * (fr >> 2) + (fr & 3)) * K + w * ksl + 8 * fq;
        f32x4 acc[4][2][2];
#pragma unroll
        for (int m = 0; m < 4; ++m)
#pragma unroll
            for (int g = 0; g < 2; ++g)
#pragma unroll
                for (int n = 0; n < 2; ++n) acc[m][g][n] = (f32x4){0.f, 0.f, 0.f, 0.f};
        bf16x8 a0[4], b0[4], a1[4], b1[4];
#define SG_LOAD(af, bf_, s_) do { _Pragma("unroll") for (int m = 0; m < 4; ++m) af[m] = *(const bf16x8*)(ap + (size_t)(16 * m) * lda + 32 * (s_)); \
        _Pragma("unroll") for (int gn = 0; gn < 4; ++gn) bf_[gn] = *(const bf16x8*)(bp + (size_t)(32 * (gn >> 1) + 4 * (gn & 1)) * K + 32 * (s_)); } while (0)
#define SG_MMA(af, bf_) do { _Pragma("unroll") for (int m = 0; m < 4; ++m) _Pragma("unroll") for (int gn = 0; gn < 4; ++gn) \
        acc[m][gn >> 1][gn & 1] = __builtin_amdgcn_mfma_f32_16x16x32_bf16(bf_[gn], af[m], acc[m][gn >> 1][gn & 1], 0, 0, 0); } while (0)
        SG_LOAD(a0, b0, 0);
        int s = 0;
        for (; s + 1 < nks; s += 2) { SG_LOAD(a1, b1, s + 1); SG_MMA(a0, b0); if (s + 2 < nks) SG_LOAD(a0, b0, s + 2); SG_MMA(a1, b1); }
        if (nks & 1) SG_MMA(a0, b0);
#undef SG_LOAD
#undef SG_MMA
        __syncthreads();
#pragma unroll
        for (int m = 0; m < 4; ++m)
#pragma unroll
            for (int g = 0; g < 2; ++g)
#pragma unroll
                for (int n = 0; n < 2; ++n) { const int row = 16 * m + fr, c4 = 8 * g + 2 * fq + n; *(LAS f32x4*)(lds + w * 16384 + row * 256 + ((c4 ^ (row & 7)) << 4)) = acc[m][g][n]; }
        __syncthreads();
        const int row = tid >> 3, cg = tid & 7; float v[8];
#pragma unroll
        for (int e = 0; e < 8; ++e) v[e] = 0.f;
#pragma unroll
        for (int ww = 0; ww < 8; ++ww) { const f32x4 p0 = *(const LAS f32x4*)(lds + ww * 16384 + row * 256 + (((2 * cg) ^ (row & 7)) << 4)), p1 = *(const LAS f32x4*)(lds + ww * 16384 + row * 256 + (((2 * cg + 1) ^ (row & 7)) << 4));
#pragma unroll
            for (int e = 0; e < 4; ++e) { v[e] += p0[e]; v[4 + e] += p1[e]; } }
        E.small(row0 + row, col0 + 8 * cg, v, cb, cg);
    }
    __syncthreads();
}
}

constexpr int NWAVES = 8, NTHR = NWAVES * 64;
constexpr int RING_BYTES = 131072, LDSCTL_OFF = RING_BYTES, MISC_OFF = LDSCTL_OFF + 320, LDS_BYTES = 147456;
typedef GAS unsigned gu32;
#define RLX_AGENT __ATOMIC_RELAXED, __HIP_MEMORY_SCOPE_AGENT

#define XB_TMO      128
#define XB_XCNT(j)  (256  + 64 * (j))
#define XB_XSUB(j)  (1280 + 64 * (j))
#define XB_XGEN(j)  (2304 + 64 * (j))
#define XB_TOP      3328
#define XB_TOPGEN   3392
#define XCD_BAR_WORDS 3456
#define XB_SPIN_CAP (1u << 18)
constexpr int CW_BAR = 4096;
__device__ __forceinline__ unsigned xb_ld(unsigned* p)              { return __hip_atomic_load(p, __ATOMIC_RELAXED, __HIP_MEMORY_SCOPE_AGENT); }
__device__ __forceinline__ unsigned xb_add(unsigned* p, unsigned v) { return __hip_atomic_fetch_add(p, v, __ATOMIC_RELAXED, __HIP_MEMORY_SCOPE_AGENT); }
__device__ __forceinline__ unsigned xb_xcc_id() { return (unsigned)__builtin_amdgcn_s_getreg((3 << 11) | 20) & 0xFu; }
#define XB_SPIN(cond, bar) do { unsigned _sp = 0; while (cond) { __builtin_amdgcn_s_sleep(1); \
    if ((++_sp & 255u) == 0u) { if (xb_ld(&(bar)[XB_TMO])) break; if (_sp > XB_SPIN_CAP) { atomicAdd(&(bar)[XB_TMO], 1u); break; } } } } while (0)
struct XcdBarrier { unsigned* bar; unsigned x; volatile LAS unsigned* st; };
__device__ __forceinline__ XcdBarrier xcd_barrier_post(unsigned* bar, volatile LAS unsigned* st) {
    XcdBarrier b; b.bar = bar; b.x = xb_xcc_id(); b.st = st;
    if (threadIdx.x == 0) (void)xb_add(&bar[XB_XCNT(b.x)], 1u);
    return b;
}
__device__ __forceinline__ void xcd_barrier_complete(unsigned* bar, unsigned x, unsigned& nloc, unsigned& nx) {
    const unsigned G = gridDim.x * gridDim.y * gridDim.z;
    unsigned sum, cnt, mine, sp = 0u;
    for (;;) {
        sum = 0u; cnt = 0u; mine = 0u;
#pragma unroll
        for (unsigned j = 0; j < 16; ++j) { const unsigned c = xb_ld(&bar[XB_XCNT(j)]); sum += c; cnt += (c > 0u) ? 1u : 0u; mine = (j == x) ? c : mine; }
        if (sum == G) break;
        __builtin_amdgcn_s_sleep(1);
        if ((++sp & 255u) == 0u) { if (xb_ld(&bar[XB_TMO])) break; if (sp > XB_SPIN_CAP) { atomicAdd(&bar[XB_TMO], 1u); break; } }
    }
    nloc = mine > 0u ? mine : 1u; nx = cnt > 0u ? cnt : 1u;
}
__device__ __forceinline__ void xcd_barrier(const XcdBarrier& b) {
    asm volatile("s_waitcnt vmcnt(0)" ::: "memory");
    __syncthreads();
    if (threadIdx.x == 0) {
        unsigned* bar = b.bar;
        __builtin_amdgcn_s_waitcnt(0);
        unsigned nloc = b.st[0], nx = b.st[1];
        if (nloc == 0u) { xcd_barrier_complete(bar, b.x, nloc, nx); b.st[0] = nloc; b.st[1] = nx; }
        const unsigned old = xb_add(&bar[XB_XSUB(b.x)], 1u);
        const unsigned gen = old / nloc;
        if (old + 1u == (gen + 1u) * nloc) {
            __builtin_amdgcn_fence(__ATOMIC_RELEASE, "agent");
            asm volatile("s_waitcnt vmcnt(0)" ::: "memory");
            const unsigned og = xb_add(&bar[XB_TOP], 1u);
            const unsigned tg = og / nx;
            if (og + 1u == (tg + 1u) * nx) xb_add(&bar[XB_TOPGEN], 1u);
            else XB_SPIN(xb_ld(&bar[XB_TOPGEN]) == tg, bar);
            __builtin_amdgcn_fence(__ATOMIC_ACQUIRE, "agent");
            xb_add(&bar[XB_XGEN(b.x)], 1u);
            asm volatile("s_waitcnt vmcnt(0)" ::: "memory");
        } else {
            XB_SPIN(xb_ld(&bar[XB_XGEN(b.x)]) == gen, bar);
            __builtin_amdgcn_fence(__ATOMIC_ACQUIRE, "agent");
            asm volatile("s_waitcnt vmcnt(0)" ::: "memory");
        }
    }
    __syncthreads();
}

struct Args {
    const float* in[26]; float* out; unsigned char* ws; int ph_lo, ph_hi;
};
struct Frame {
    LAS unsigned char* lds; int tid, lane, wave, vcu, G;
};
typedef const __attribute__((address_space(4))) Args* KArgs;
__device__ __forceinline__ bf16_t* wl_base(KArgs a, int l) {
    return l < 2 ? (bf16_t*)(a->out + O_SDNS + (size_t)NB_S * NH * HD * HD) + (size_t)l * WL_SIZE : (bf16_t*)(a->ws + WS_W23) + (size_t)(l - 2) * WL_SIZE;
}
__device__ __forceinline__ float* vec_base(KArgs a, int l) { return (float*)(a->ws + WS_VEC) + (size_t)l * VEC_L; }

template <bool UPMAP>
__device__ __forceinline__ void p0_transpose_item(const float* W, int K, int N, int ldn, const float* gk, bf16_t* WT, LAS float* scr, int item, int nblk, int lane) {
    const int kb = item / nblk, nb = item % nblk, k0 = 64 * kb, n0 = 32 * nb;
    const int ns0 = UPMAP ? (((nb >> 2) & 1) ? DFF : 0) + 128 * (nb >> 3) + 32 * (nb & 3) : n0;
    const int nq = lane & 7, n = ns0 + 4 * nq, kr = lane >> 3;
    f32x4 v[8];
#pragma unroll
    for (int i = 0; i < 8; ++i) v[i] = (n < N) ? *(const f32x4*)(W + (size_t)(k0 + kr + 8 * i) * ldn + n) : (f32x4){0.f, 0.f, 0.f, 0.f};
#pragma unroll
    for (int i = 0; i < 8; ++i) { const int kk = kr + 8 * i; if (gk) v[i] = v[i] * gk[k0 + kk];
#pragma unroll
        for (int e = 0; e < 4; ++e) scr[kk * 33 + 4 * nq + e] = v[i][e]; }
    asm volatile("s_waitcnt lgkmcnt(0)" ::: "memory");
    const int c = lane & 7;
#pragma unroll
    for (int j = 0; j < 4; ++j) { const int nn = (lane >> 3) + 8 * j; const LAS float* s = scr + (8 * c) * 33 + nn;
        u32x4 o; o.x = cvtpk(s[0 * 33], s[1 * 33]); o.y = cvtpk(s[2 * 33], s[3 * 33]); o.z = cvtpk(s[4 * 33], s[5 * 33]); o.w = cvtpk(s[6 * 33], s[7 * 33]);
        *(u32x4*)(WT + (size_t)(n0 + nn) * K + k0 + 8 * c) = o; }
    asm volatile("s_waitcnt lgkmcnt(0)" ::: "memory");
}
template <bool UPMAP = false>
__device__ __forceinline__ void p0_transpose(const Frame& F, const float* W, int K, int N, int Npad, const float* gk, bf16_t* WT) {
    LAS float* scr = (LAS float*)(F.lds + F.wave * 16384);
    const int gw = F.vcu * NWAVES + F.wave, NGW = F.G * NWAVES, nblk = Npad / 32, nitems = (K / 64) * nblk;
    for (int it = gw; it < nitems; it += NGW) p0_transpose_item<UPMAP>(W, K, N, N, gk, WT, scr, it, nblk, F.lane);
}
__device__ __forceinline__ void p0_prologue(const Frame& F, KArgs a) {
    for (int l = 0; l < DEPTH; ++l) {
        bf16_t* wb = wl_base(a, l); const int j = l >> 1;
        if ((l & 1) == 0) { p0_transpose(F, a->in[8] + (size_t)j * D * AIN, D, AIN, 4352, nullptr, wb + WL_IN); p0_transpose(F, a->in[13] + (size_t)j * D * D, D, D, D, nullptr, wb + WL_OUT); }
        else { p0_transpose(F, a->in[14] + (size_t)j * D * 3 * D, D, 3 * D, 3 * D, nullptr, wb + WL_IN); p0_transpose(F, a->in[16] + (size_t)j * D * D, D, D, D, nullptr, wb + WL_OUT); }
        p0_transpose<true>(F, a->in[17] + (size_t)l * D * DFF2, D, DFF2, DFF2, a->in[20] + l * D, wb + WL_UP);
        p0_transpose(F, a->in[19] + (size_t)l * DFF * D, DFF, D, D, nullptr, wb + WL_DOWN);
        p0_transpose(F, a->in[25] + (size_t)l * D * D, D, D, D, a->in[22] + l * D, wb + WL_G);
        p0_transpose(F, a->in[24] + (size_t)l * DPLE * D, DPLE, D, D, nullptr, wb + WL_P);
    }
    const int gt = F.vcu * NTHR + F.tid, NGT = F.G * NTHR;
    {
        LAS float* red = (LAS float*)(F.lds + NWAVES * 16384 - 8192);
        constexpr int NBLK = (DFF2 + D) / 64;
        for (int it = F.vcu; it < DEPTH * NBLK; it += F.G) {
            const int l = it / NBLK, n0 = (it % NBLK) * 64; const bool up = n0 < DFF2; const int n = (up ? n0 : n0 - DFF2) + F.lane, N = up ? DFF2 : D;
            const int nsrc = up ? (((n >> 7) & 1) ? DFF : 0) + 128 * (n >> 8) + (n & 127) : n;
            const float* W = (up ? a->in[17] + (size_t)l * D * DFF2 : a->in[25] + (size_t)l * D * D) + nsrc;
            const float* g = (up ? a->in[20] : a->in[22]) + l * D; const float* b = (up ? a->in[21] : a->in[23]) + l * D;
            float s1 = 0.f, s2 = 0.f; const int k0 = 128 * F.wave;
#pragma unroll 16
            for (int k = k0; k < k0 + 128; ++k) { const float w = W[(size_t)k * N]; s1 += bf2f(f2bf(g[k] * w)); s2 += b[k] * w; }
            __syncthreads();
            red[(F.wave * 64 + F.lane) * 2] = s1; red[(F.wave * 64 + F.lane) * 2 + 1] = s2;
            __syncthreads();
            if (F.tid < 128) { const int c = F.tid >> 1, which = F.tid & 1; float t = 0.f;
#pragma unroll
                for (int w8 = 0; w8 < 8; ++w8) t += red[(w8 * 64 + c) * 2 + which];
                float* vb = vec_base(a, l); const int nn = (up ? n0 : n0 - DFF2) + c;
                vb[(up ? 0 : 2 * DFF2) + (which ? (up ? DFF2 : D) : 0) + nn] = t; }
        }
        __syncthreads();
    }
    bf16_t* X0 = (bf16_t*)(a->ws + WS_X0); bf16_t* PB = (bf16_t*)(a->ws + WS_PB);
#pragma unroll 4
    for (size_t i = gt; i < (size_t)M * D / 8; i += NGT) { const size_t e = i * 8; const float* src = e < (size_t)M_P * D ? a->in[0] + e : a->in[1] + (e - (size_t)M_P * D);
        const f32x4 v0 = *(const f32x4*)src, v1 = *(const f32x4*)(src + 4); u32x4 w; w.x = pk2(v0[0], v0[1]); w.y = pk2(v0[2], v0[3]); w.z = pk2(v1[0], v1[1]); w.w = pk2(v1[2], v1[3]); *(u32x4*)(X0 + e) = w; }
#pragma unroll 4
    for (size_t i = gt; i < (size_t)DEPTH * M * DPLE / 8; i += NGT) { const size_t e = i * 8; const size_t l = e / ((size_t)M * DPLE), r = e % ((size_t)M * DPLE);
        const float* src = r < (size_t)M_P * DPLE ? a->in[2] + l * (size_t)M_P * DPLE + r : a->in[3] + l * (size_t)M_S * DPLE + (r - (size_t)M_P * DPLE);
        const f32x4 v0 = *(const f32x4*)src, v1 = *(const f32x4*)(src + 4); u32x4 w; w.x = pk2(v0[0], v0[1]); w.y = pk2(v0[2], v0[3]); w.z = pk2(v1[0], v1[1]); w.w = pk2(v1[2], v1[3]); *(u32x4*)(PB + e) = w; }
}

__device__ __forceinline__ void dn_chunk_phase(const Frame& F, KArgs a, int j) {
    const bf16_t* proj = (const bf16_t*)(a->ws + WS_R1); const float* ba = (const float*)(a->ws + WS_BA);
    const float* cw = a->in[9] + (size_t)j * 4 * QKV;
    LAS float* Am = (LAS float*)(F.lds);
    LAS float* sc = (LAS float*)(F.lds + 17408);
    LAS unsigned char* kn = F.lds + 18432;
    LAS unsigned char* qn = F.lds + 35840;
    LAS float* vv = (LAS float*)(F.lds + 53248);
    LAS unsigned char* wb = F.lds + 86016;
    const int tid = F.tid, lane = F.lane, wave = F.wave;
    for (int cu = F.vcu; cu < N_CU; cu += F.G) {
        const int n = cu & 31, h = (cu >> 5) & 7, b = cu >> 8, rowbase = b * SEQ + n * 64;
        unsigned char* cub = a->ws + WS_R2 + (size_t)cu * CU_BYTES;
        if (wave == 0) {
            const int r = rowbase + lane;
            const float b1 = ba[(size_t)r * 16 + h], b2 = ba[(size_t)r * 16 + 8 + h] + a->in[11][j * 8 + h];
            const float sp = b2 > 20.f ? b2 : log1pf(expf(b2));
            float c = -expf(a->in[10][j * 8 + h]) * sp;
#pragma unroll
            for (int o = 1; o < 64; o <<= 1) { const float t = __shfl_up(c, o); if (lane >= o) c += t; }
            const float gl = __shfl(c, 63);
            sc[lane] = c; sc[64 + lane] = sigmoidf_(b1); sc[128 + lane] = __expf(c); sc[192 + lane] = __expf(gl - c);
            if (lane == 0) ((float*)(a->ws + WS_R2 + R2_DEC))[cu] = __expf(gl);
        }
        __syncthreads();
#pragma unroll 1
        for (int crep = 0; crep < MK_CONV_REP; ++crep)
        if (tid < 384) {
            const int tb = tid / 48, pg = tid % 48, part = pg >> 4, g8 = pg & 15, col = part * 1024 + h * HD + 8 * g8, t0 = n * 64 + 8 * tb, r0 = rowbase + 8 * tb;
            u32x4 raw[11];
#pragma unroll
            for (int q = 0; q < 11; ++q) raw[q] = (t0 + q - 3 >= 0) ? *(const u32x4*)(proj + (size_t)(r0 + q - 3) * PROJW + col) : (u32x4){0u, 0u, 0u, 0u};
            f32x4 wv[4][2];
#pragma unroll
            for (int jj = 0; jj < 4; ++jj) { wv[jj][0] = *(const f32x4*)(cw + (size_t)jj * QKV + col); wv[jj][1] = *(const f32x4*)(cw + (size_t)jj * QKV + col + 4); }
#pragma unroll
            for (int e = 0; e < 8; ++e) {
                const int tok = 8 * tb + e; float y[8];
#pragma unroll
                for (int c = 0; c < 8; ++c) y[c] = 0.f;
#pragma unroll
                for (int jj = 0; jj < 4; ++jj) { float u[8]; unpack8(raw[e + jj], u);
#pragma unroll
                    for (int c = 0; c < 4; ++c) { y[c] += wv[jj][0][c] * u[c]; y[4 + c] += wv[jj][1][c] * u[4 + c]; }
                    if (jj == 3 && t0 + e >= SEQ - 3) { float* o = a->out + O_PDNC + (((size_t)j * NB_P + b) * 3 + (t0 + e - (SEQ - 3))) * QKV + col;
                        *(f32x4*)o = (f32x4){u[0], u[1], u[2], u[3]}; *(f32x4*)(o + 4) = (f32x4){u[4], u[5], u[6], u[7]}; } }
                float ss = 0.f;
#pragma unroll
                for (int c = 0; c < 8; ++c) { y[c] = siluf_(y[c]); ss += y[c] * y[c]; }
                if (part < 2) {
                    ss += __shfl_xor(ss, 1); ss += __shfl_xor(ss, 2); ss += __shfl_xor(ss, 4); ss += __shfl_xor(ss, 8);
                    const float sl = rsqrtf(ss + L2_EPS) * (part == 0 ? QSCALE : 1.0f);
                    u32x4 w; w.x = cvtpk(y[0] * sl, y[1] * sl); w.y = cvtpk(y[2] * sl, y[3] * sl); w.z = cvtpk(y[4] * sl, y[5] * sl); w.w = cvtpk(y[6] * sl, y[7] * sl);
                    *(LAS u32x4*)((part == 0 ? qn : kn) + tok * 272 + g8 * 16) = w;
                } else {
                    const float bt = sc[64 + tok];
                    *(LAS f32x4*)(vv + tok * 128 + 8 * g8) = (f32x4){y[0] * bt, y[1] * bt, y[2] * bt, y[3] * bt}; *(LAS f32x4*)(vv + tok * 128 + 8 * g8 + 4) = (f32x4){y[4] * bt, y[5] * bt, y[6] * bt, y[7] * bt};
                }
            }
        }
        __syncthreads();
        if (wave < 6) {
            const int kind = wave >= 3, pr = wave - 3 * kind, mj = pr == 2, mi = pr >= 1, r32 = lane & 31, hh = lane >> 5;
            f32x16 acc;
#pragma unroll
            for (int e = 0; e < 16; ++e) acc[e] = 0.f;
            const LAS unsigned char* ap = kn + (32 * mj + r32) * 272 + hh * 16; const LAS unsigned char* bp = (kind ? qn : kn) + (32 * mi + r32) * 272 + hh * 16;
#pragma unroll
            for (int s = 0; s < 8; ++s) acc = __builtin_amdgcn_mfma_f32_32x32x16_bf16(*(const LAS bf16x8*)(ap + 32 * s), *(const LAS bf16x8*)(bp + 32 * s), acc, 0, 0, 0);
            const int i = 32 * mi + r32; const float gci = sc[i], bi = sc[64 + i];
            if (kind == 0) {
#pragma unroll
                for (int q4 = 0; q4 < 4; ++q4) { const int j0 = 32 * mj + 8 * q4 + 4 * hh; f32x4 o;
#pragma unroll
                    for (int e = 0; e < 4; ++e) { const int jj = j0 + e; o[e] = (i > jj) ? bi * acc[4 * q4 + e] * __expf(fminf(gci - sc[jj], 0.f)) : 0.f; }
                    *(LAS f32x4*)(Am + i * 68 + j0) = o; }
            } else {
#pragma unroll
                for (int s = 0; s < 2; ++s) { float v[8];
#pragma unroll
                    for (int e = 0; e < 8; ++e) { const int jj = 32 * mj + crow(8 * s + e, hh); v[e] = (i >= jj) ? acc[8 * s + e] * __expf(fminf(gci - sc[jj], 0.f)) : 0.f; }
                    u32x4 w; w.x = cvtpk(v[0], v[1]); w.y = cvtpk(v[2], v[3]); w.z = cvtpk(v[4], v[5]); w.w = cvtpk(v[6], v[7]);
                    *(u32x4*)(cub + CU_AF + (pr * 2 + s) * 1024 + lane * 16) = w; }
            }
        }
        __syncthreads();
        if (wave < 4) {
#pragma unroll 1
            for (int srep = 0; srep < MK_SUB_REP; ++srep) {
            float X[64];
            if (wave < 2) {
#pragma unroll
                for (int i = 0; i < 64; ++i) X[i] = vv[i * 128 + 64 * wave + lane];
            } else {
#pragma unroll
                for (int i = 0; i < 64; ++i) X[i] = bf2f(*(const LAS unsigned short*)(kn + i * 272 + (64 * (wave - 2) + lane) * 2)) * (sc[64 + i] * sc[128 + i]);
            }
            f32x4 ring[3][8]; float a0 = 0.f, a1 = 0.f;
#define HR_ROW(s) ((s) < 32 ? (s) + 1 : 33 + (((s) - 32) >> 1))
#define HR_HALF(s) ((s) < 32 ? 0 : (((s) - 32) & 1))
#define HR_LOAD(s) do { const int i_ = HR_ROW(s), h_ = HR_HALF(s), c0_ = 32 * h_, c1_ = h_ ? i_ : (i_ < 32 ? i_ : 32); \
                _Pragma("unroll") for (int q = 0; q < (c1_ - c0_ + 3) / 4; ++q) ring[(s) % 3][q] = *(const LAS f32x4*)(Am + i_ * 68 + c0_ + 4 * q); } while (0)
            HR_LOAD(0); HR_LOAD(1);
#pragma unroll
            for (int sI = 0; sI < 94; ++sI) {
                if (sI + 2 < 94) HR_LOAD(sI + 2);
                __builtin_amdgcn_sched_barrier(0);
                const int i = HR_ROW(sI), hf = HR_HALF(sI), c0 = 32 * hf, c1 = hf ? i : (i < 32 ? i : 32);
                if (hf == 0) { a0 = X[i]; a1 = 0.f; }
#pragma unroll
                for (int j4 = c0; j4 < c1; j4 += 4) { const f32x4 av = ring[sI % 3][(j4 - c0) >> 2];
                    a0 -= av[0] * X[j4]; if (j4 + 1 < c1) a1 -= av[1] * X[j4 + 1]; if (j4 + 2 < c1) a0 -= av[2] * X[j4 + 2]; if (j4 + 3 < c1) a1 -= av[3] * X[j4 + 3]; }
                if (hf == 1 || i <= 32) X[i] = a0 + a1;
                __builtin_amdgcn_sched_barrier(0);
            }
#undef HR_ROW
#undef HR_HALF
#undef HR_LOAD
            if (wave < 2) { float* U = (float*)(cub + CU_U) + 64 * wave + lane;
#pragma unroll
                for (int i = 0; i < 64; ++i) U[i * 128] = X[i];
            } else {
#pragma unroll
                for (int i = 0; i < 64; ++i) *(LAS unsigned short*)(wb + i * 272 + (64 * (wave - 2) + lane) * 2) = (unsigned short)f2bf(X[i]);
            }
            }
        } else {
            const int t2 = tid - 256;
#pragma unroll 1
            for (int k = 0; k < 4; ++k) { const int vi = t2 + 256 * k, f = vi >> 6, ln = vi & 63, r32 = ln & 31, hh = ln >> 5;
                { const int mtok = f >> 3, mt = (f >> 1) & 3, s = f & 1, tok = 32 * mtok + r32, kd0 = 32 * mt + 16 * s + 4 * hh; const float eg = sc[128 + tok];
                  const u32x2 lo = *(const LAS u32x2*)(qn + tok * 272 + kd0 * 2), hi = *(const LAS u32x2*)(qn + tok * 272 + (kd0 + 8) * 2);
                  u32x4 w; w.x = cvtpk(bf2f(lo.x & 0xffffu) * eg, bf2f(lo.x >> 16) * eg); w.y = cvtpk(bf2f(lo.y & 0xffffu) * eg, bf2f(lo.y >> 16) * eg);
                  w.z = cvtpk(bf2f(hi.x & 0xffffu) * eg, bf2f(hi.x >> 16) * eg); w.w = cvtpk(bf2f(hi.y & 0xffffu) * eg, bf2f(hi.y >> 16) * eg);
                  *(u32x4*)(cub + CU_QF + f * 1024 + ln * 16) = w; }
                { const int mt = f >> 2, mtok = (f >> 1) & 1, s = f & 1, kd = 32 * mt + r32; float v[8];
#pragma unroll
                  for (int e = 0; e < 8; ++e) { const int tk = 32 * mtok + 16 * s + 8 * (e >> 2) + 4 * hh + (e & 3); v[e] = bf2f(*(const LAS unsigned short*)(kn + tk * 272 + kd * 2)) * sc[192 + tk]; }
                  u32x4 w; w.x = cvtpk(v[0], v[1]); w.y = cvtpk(v[2], v[3]); w.z = cvtpk(v[4], v[5]); w.w = cvtpk(v[6], v[7]);
                  *(u32x4*)(cub + CU_KF + f * 1024 + ln * 16) = w; }
            }
        }
        __syncthreads();
#pragma unroll 1
        for (int k = 0; k < 2; ++k) { const int vi = tid + 512 * k, f = vi >> 6, ln = vi & 63, r32 = ln & 31, hh = ln >> 5;
            const int mtok = f >> 3, mt = (f >> 1) & 3, s = f & 1, tok = 32 * mtok + r32, kd0 = 32 * mt + 16 * s + 4 * hh;
            const u32x2 lo = *(const LAS u32x2*)(wb + tok * 272 + kd0 * 2), hi = *(const LAS u32x2*)(wb + tok * 272 + (kd0 + 8) * 2);
            *(u32x4*)(cub + CU_WF + f * 1024 + ln * 16) = (u32x4){lo.x, lo.y, hi.x, hi.y}; }
        __syncthreads();
    }
}

__device__ __forceinline__ void dn_scan_unit(const Frame& F, KArgs a, int j, int bh) {
    const int w = F.wave, lane = F.lane;
    const unsigned char* cub = a->ws + WS_R2 + (size_t)bh * 32 * CU_BYTES;
    if (w >= 4) {
        const int lw = w - 4;
        for (int n = 0; n <= 32; ++n) {
            if (n < 32) { const unsigned char* src = cub + (size_t)n * CU_BYTES + lane * 16; LAS unsigned char* dst = F.lds + (n & 1) * CU_LDS;
                for (int pc = lw; pc < 54; pc += 4) __builtin_amdgcn_global_load_lds((const unsigned*)(src + pc * 1024), (LAS unsigned*)(dst + pc * 1024), 16, 0, 0); }
            asm volatile("s_waitcnt vmcnt(0)" ::: "memory");
            __syncthreads();
        }
    } else {
        const int v = lane & 31, hh = lane >> 5, b = bh >> 3, h = bh & 7;
        f32x16 S[4];
#pragma unroll
        for (int mt = 0; mt < 4; ++mt)
#pragma unroll
            for (int e = 0; e < 16; ++e) S[mt][e] = 0.f;
        const float* decp = (const float*)(a->ws + WS_R2 + R2_DEC) + bh * 32;
        float* Og = (float*)(a->ws + WS_R1);
        __syncthreads();
        for (int n = 0; n < 32; ++n) {
            const LAS unsigned char* buf = F.lds + (n & 1) * CU_LDS + lane * 16;
            const float* U = (const float*)(cub + (size_t)n * CU_BYTES + CU_U) + 32 * w + v;
            f32x16 un[2];
#pragma unroll
            for (int mtok = 0; mtok < 2; ++mtok)
#pragma unroll
                for (int e = 0; e < 16; ++e) un[mtok][e] = U[(32 * mtok + crow(e, hh)) * 128];
            const float dec = decp[n];
            bf16x8 Sb[4][2];
#pragma unroll
            for (int mt = 0; mt < 4; ++mt)
#pragma unroll
                for (int s = 0; s < 2; ++s) { u32x4 p; p.x = cvtpk(S[mt][8 * s], S[mt][8 * s + 1]); p.y = cvtpk(S[mt][8 * s + 2], S[mt][8 * s + 3]); p.z = cvtpk(S[mt][8 * s + 4], S[mt][8 * s + 5]); p.w = cvtpk(S[mt][8 * s + 6], S[mt][8 * s + 7]);
                    Sb[mt][s] = __builtin_bit_cast(bf16x8, p); }
            f32x16 acc[2];
#pragma unroll
            for (int mtok = 0; mtok < 2; ++mtok) {
#pragma unroll
                for (int e = 0; e < 16; ++e) acc[mtok][e] = 0.f;
#pragma unroll
                for (int mt = 0; mt < 4; ++mt)
#pragma unroll
                    for (int s = 0; s < 2; ++s) acc[mtok] = __builtin_amdgcn_mfma_f32_32x32x16_bf16(*(const LAS bf16x8*)(buf + CU_WF + ((mtok * 4 + mt) * 2 + s) * 1024), Sb[mt][s], acc[mtok], 0, 0, 0);
            }
            bf16x8 vnb[2][2];
#pragma unroll
            for (int mtok = 0; mtok < 2; ++mtok) {
#pragma unroll
                for (int e = 0; e < 16; ++e) acc[mtok][e] = un[mtok][e] - acc[mtok][e];
#pragma unroll
                for (int s = 0; s < 2; ++s) { u32x4 p; p.x = cvtpk(acc[mtok][8 * s], acc[mtok][8 * s + 1]); p.y = cvtpk(acc[mtok][8 * s + 2], acc[mtok][8 * s + 3]); p.z = cvtpk(acc[mtok][8 * s + 4], acc[mtok][8 * s + 5]); p.w = cvtpk(acc[mtok][8 * s + 6], acc[mtok][8 * s + 7]);
                    vnb[mtok][s] = __builtin_bit_cast(bf16x8, p); }
            }
#pragma unroll
            for (int mtok = 0; mtok < 2; ++mtok) {
                f32x16 o;
#pragma unroll
                for (int e = 0; e < 16; ++e) o[e] = 0.f;
#pragma unroll
                for (int mt = 0; mt < 4; ++mt)
#pragma unroll
                    for (int s = 0; s < 2; ++s) o = __builtin_amdgcn_mfma_f32_32x32x16_bf16(*(const LAS bf16x8*)(buf + CU_QF + ((mtok * 4 + mt) * 2 + s) * 1024), Sb[mt][s], o, 0, 0, 0);
#pragma unroll
                for (int mp = 0; mp <= mtok; ++mp)
#pragma unroll
                    for (int s = 0; s < 2; ++s) o = __builtin_amdgcn_mfma_f32_32x32x16_bf16(*(const LAS bf16x8*)(buf + CU_AF + ((mtok + mp) * 2 + s) * 1024), vnb[mp][s], o, 0, 0, 0);
                float* op = Og + (size_t)(b * SEQ + n * 64 + 32 * mtok) * OLD + h * HD + 32 * w + v;
#pragma unroll
                for (int e = 0; e < 16; ++e) op[(size_t)crow(e, hh) * OLD] = o[e];
            }
#pragma unroll
            for (int mt = 0; mt < 4; ++mt) {
#pragma unroll
                for (int e = 0; e < 16; ++e) S[mt][e] *= dec;
#pragma unroll
                for (int mtok = 0; mtok < 2; ++mtok)
#pragma unroll
                    for (int s = 0; s < 2; ++s) S[mt] = __builtin_amdgcn_mfma_f32_32x32x16_bf16(*(const LAS bf16x8*)(buf + CU_KF + ((mt * 2 + mtok) * 2 + s) * 1024), vnb[mtok][s], S[mt], 0, 0, 0);
            }
            __syncthreads();
        }
        float* so = a->out + O_PDNS + ((size_t)j * NB_P * NH + bh) * HD * HD + 32 * w + v;
#pragma unroll
        for (int mt = 0; mt < 4; ++mt)
#pragma unroll
            for (int e = 0; e < 16; ++e) so[(size_t)(32 * mt + crow(e, hh)) * HD] = S[mt][e];
    }
}

__device__ __forceinline__ void dn_sample_unit(const Frame& F, KArgs a, int j, int u) {
    const int tid = F.tid, b = u >> 3, h = u & 7, row0 = M_P + b * DSEQ;
    const bf16_t* proj = (const bf16_t*)(a->ws + WS_R1); const float* ba = (const float*)(a->ws + WS_BA);
    const float* cw = a->in[9] + (size_t)j * 4 * QKV; const float* sbuf = a->in[4] + ((size_t)j * NB_S + b) * 3 * QKV;
    LAS float* qn = (LAS float*)F.lds;
    LAS float* kn = qn + 1024;
    LAS float* vb = kn + 1024;
    LAS float* ul = vb + 1024;
    LAS float* wl = ul + 1024;
    LAS float* vn = wl + 1024;
    LAS float* A8 = vn + 1024;
    LAS float* T8 = A8 + 64;
    LAS float* sc = T8 + 64;
    LAS float* red = sc + 64;
    __syncthreads();
    if (tid < 8) {
        const int r = row0 + tid;
        const float b1 = ba[(size_t)r * 16 + h], b2 = ba[(size_t)r * 16 + 8 + h] + a->in[11][j * 8 + h];
        const float sp = b2 > 20.f ? b2 : log1pf(expf(b2));
        float c = -expf(a->in[10][j * 8 + h]) * sp;
#pragma unroll
        for (int o = 1; o < 8; o <<= 1) { const float t = __shfl_up(c, o); if (tid >= o) c += t; }
        const float gl = __shfl(c, 7);
        sc[tid] = c; sc[8 + tid] = sigmoidf_(b1); sc[16 + tid] = __expf(c); sc[24 + tid] = __expf(gl - c); if (tid == 0) sc[32] = __expf(gl);
    }
    __syncthreads();
    if (tid < 384) {
        const int rr = tid >> 4, part = rr >> 3, tok = rr & 7, g8 = tid & 15, col = part * 1024 + h * HD + 8 * g8, r = row0 + tok;
        float y[8];
#pragma unroll
        for (int e = 0; e < 8; ++e) y[e] = 0.f;
#pragma unroll
        for (int jj = 0; jj < 4; ++jj) { const int d = 3 - jj; float uu[8];
            if (tok - d >= 0) unpack8(*(const u32x4*)(proj + (size_t)(r - d) * PROJW + col), uu);
            else { const float* p = sbuf + (size_t)(tok + jj) * QKV + col;
#pragma unroll
                for (int e = 0; e < 8; ++e) uu[e] = p[e]; }
            const f32x4 w0 = *(const f32x4*)(cw + (size_t)jj * QKV + col), w1 = *(const f32x4*)(cw + (size_t)jj * QKV + col + 4);
#pragma unroll
            for (int e = 0; e < 4; ++e) { y[e] += w0[e] * uu[e]; y[4 + e] += w1[e] * uu[4 + e]; }
            if (jj == 3 && tok >= DSEQ - 3) { float* o = a->out + O_SDNC + (((size_t)j * NB_S + b) * 3 + (tok - (DSEQ - 3))) * QKV + col;
                *(f32x4*)o = (f32x4){uu[0], uu[1], uu[2], uu[3]}; *(f32x4*)(o + 4) = (f32x4){uu[4], uu[5], uu[6], uu[7]}; } }
        float ss = 0.f;
#pragma unroll
        for (int e = 0; e < 8; ++e) { y[e] = siluf_(y[e]); ss += y[e] * y[e]; }
        ss += __shfl_xor(ss, 1); ss += __shfl_xor(ss, 2); ss += __shfl_xor(ss, 4); ss += __shfl_xor(ss, 8);
        const float sl = part == 0 ? rsqrtf(ss + L2_EPS) * QSCALE : (part == 1 ? rsqrtf(ss + L2_EPS) : sc[8 + tok]);
        LAS float* dst = (part == 0 ? qn : (part == 1 ? kn : vb)) + tok * 128 + 8 * g8;
        *(LAS f32x4*)dst = (f32x4){y[0] * sl, y[1] * sl, y[2] * sl, y[3] * sl}; *(LAS f32x4*)(dst + 4) = (f32x4){y[4] * sl, y[5] * sl, y[6] * sl, y[7] * sl};
    }
    __syncthreads();
    {
        const int d = tid >> 3, i = d >> 3, jx = d & 7, sub = tid & 7; float kk = 0.f, qk = 0.f;
#pragma unroll
        for (int e = 0; e < 16; ++e) { const float kj = kn[jx * 128 + 16 * sub + e]; kk += kn[i * 128 + 16 * sub + e] * kj; qk += qn[i * 128 + 16 * sub + e] * kj; }
        kk += __shfl_xor(kk, 1); kk += __shfl_xor(kk, 2); kk += __shfl_xor(kk, 4); qk += __shfl_xor(qk, 1); qk += __shfl_xor(qk, 2); qk += __shfl_xor(qk, 4);
        if (sub == 0) { const float dc = __expf(fminf(sc[i] - sc[jx], 0.f)); A8[d] = i > jx ? sc[8 + i] * kk * dc : 0.f; T8[d] = i >= jx ? qk * dc : 0.f; }
    }
    __syncthreads();
    if (tid < 256) {
        const int c = tid & 127, isw = tid >> 7; float X[8];
#pragma unroll
        for (int i = 0; i < 8; ++i) X[i] = isw ? kn[i * 128 + c] * sc[8 + i] * sc[16 + i] : vb[i * 128 + c];
#pragma unroll
        for (int i = 1; i < 8; ++i)
#pragma unroll
            for (int jx = 0; jx < i; ++jx) X[i] -= A8[i * 8 + jx] * X[jx];
        LAS float* dst = isw ? wl : ul;
#pragma unroll
        for (int i = 0; i < 8; ++i) dst[i * 128 + c] = X[i];
    }
    __syncthreads();
    const int v = tid & 127, kq = tid >> 7;
    float S[32];
    { const float* s0 = a->in[5] + (((size_t)j * NB_S + b) * NH + h) * HD * HD + (size_t)(32 * kq) * HD + v;
#pragma unroll
      for (int i = 0; i < 32; ++i) S[i] = s0[(size_t)i * HD]; }
#pragma unroll
    for (int c = 0; c < 8; ++c) { float pw = 0.f, pq = 0.f;
#pragma unroll
        for (int i4 = 0; i4 < 32; i4 += 4) { const f32x4 wv = *(const LAS f32x4*)(wl + c * 128 + 32 * kq + i4), qv = *(const LAS f32x4*)(qn + c * 128 + 32 * kq + i4);
#pragma unroll
            for (int e = 0; e < 4; ++e) { pw += wv[e] * S[i4 + e]; pq += qv[e] * S[i4 + e]; } }
        red[((0 * 4 + kq) * 8 + c) * 128 + v] = pw; red[((1 * 4 + kq) * 8 + c) * 128 + v] = pq * sc[16 + c]; }
    __syncthreads();
    float vnew[8];
#pragma unroll
    for (int c = 0; c < 8; ++c) vnew[c] = ul[c * 128 + v] - ((red[((0 * 4 + 0) * 8 + c) * 128 + v] + red[((0 * 4 + 1) * 8 + c) * 128 + v]) + (red[((0 * 4 + 2) * 8 + c) * 128 + v] + red[((0 * 4 + 3) * 8 + c) * 128 + v]));
    { const float dec = sc[32];
#pragma unroll
      for (int i = 0; i < 32; ++i) S[i] *= dec; }
#pragma unroll
    for (int c = 0; c < 8; ++c) { const float vc = vnew[c] * sc[24 + c];
#pragma unroll
        for (int i4 = 0; i4 < 32; i4 += 4) { const f32x4 kv = *(const LAS f32x4*)(kn + c * 128 + 32 * kq + i4);
#pragma unroll
            for (int e = 0; e < 4; ++e) S[i4 + e] += kv[e] * vc; } }
    { float* so = a->out + O_SDNS + (((size_t)j * NB_S + b) * NH + h) * HD * HD + (size_t)(32 * kq) * HD + v;
#pragma unroll
      for (int i = 0; i < 32; ++i) so[(size_t)i * HD] = S[i]; }
    {
        float* Og = (float*)(a->ws + WS_R2 + R2_OS);
#pragma unroll
        for (int cc = 0; cc < 2; ++cc) { const int c = 2 * kq + cc;
            float o = (red[((1 * 4 + 0) * 8 + c) * 128 + v] + red[((1 * 4 + 1) * 8 + c) * 128 + v]) + (red[((1 * 4 + 2) * 8 + c) * 128 + v] + red[((1 * 4 + 3) * 8 + c) * 128 + v]);
#pragma unroll
            for (int jx = 0; jx < 8; ++jx) o += T8[c * 8 + jx] * vnew[jx];
            Og[(size_t)(b * DSEQ + c) * D + h * HD + v] = o; }
    }
}
__device__ __forceinline__ void dn_scan_phase(const Frame& F, KArgs a, int j) {
    if ((F.vcu & 3) == 0) dn_scan_unit(F, a, j, F.vcu >> 2);
    else { const int idx = F.vcu - (F.vcu >> 2) - 1, nw = F.G - (F.G >> 2); for (int u = idx; u < NB_S * NH; u += nw) dn_sample_unit(F, a, j, u); }
}
__device__ __forceinline__ void dn_gate_phase(const Frame& F, KArgs a, int j) {
    bf16_t* proj = (bf16_t*)(a->ws + WS_R1); const float* O = (const float*)(a->ws + WS_R1); const float* ng = a->in[12] + j * HD;
    const int gw = F.vcu * NWAVES + F.wave, NGW = F.G * NWAVES, lane = F.lane;
    const f32x2 nv = *(const f32x2*)(ng + 2 * lane);
    for (int it = gw; it < M * NH; it += NGW) {
        const int r = it >> 3, h = it & 7;
        const f32x2 o = *(const f32x2*)((r < M_P ? O + (size_t)r * OLD : (const float*)(a->ws + WS_R2 + R2_OS) + (size_t)(r - M_P) * D) + h * HD + 2 * lane);
        const float rs = rsqrtf(wave_sum(o.x * o.x + o.y * o.y) * (1.0f / HD) + RMS_EPS);
        bf16_t* zp = proj + (size_t)r * PROJW + QKV + h * HD + 2 * lane; const unsigned zw = *(const unsigned*)zp;
        *(unsigned*)zp = pk2(o.x * rs * nv.x * siluf_(bf2f(zw & 0xffffu)), o.y * rs * nv.y * siluf_(bf2f(zw >> 16)));
    }
}
__device__ __forceinline__ void sc_act_phase(const Frame& F, KArgs a, int j) {
    bf16_t* proj = (bf16_t*)(a->ws + WS_R1); const float* cw = a->in[15] + (size_t)j * 3 * D; const float* sbuf = a->in[6] + (size_t)j * NB_S * 2 * D;
    const int gw = F.vcu * NWAVES + F.wave, NGW = F.G * NWAVES, lane = F.lane;
    for (int it = gw; it < M * 2; it += NGW) {
        const int r = it >> 1, c0 = (it & 1) * 512 + 8 * lane; int b, t, L; bool smp; row_info(r, b, t, L, smp);
        float y[8];
#pragma unroll
        for (int e = 0; e < 8; ++e) y[e] = 0.f;
#pragma unroll
        for (int jj = 0; jj < 3; ++jj) { const int d = 2 - jj; float u[8];
            if (t - d >= 0) { float cc[8], hh[8]; unpack8(*(const u32x4*)(proj + (size_t)(r - d) * 3072 + 1024 + c0), cc); unpack8(*(const u32x4*)(proj + (size_t)(r - d) * 3072 + 2048 + c0), hh);
#pragma unroll
                for (int e = 0; e < 8; ++e) u[e] = cc[e] * hh[e]; }
            else if (smp) { const float* p = sbuf + ((size_t)b * 2 + (t + jj)) * D + c0;
#pragma unroll
                for (int e = 0; e < 8; ++e) u[e] = p[e]; }
            else {
#pragma unroll
                for (int e = 0; e < 8; ++e) u[e] = 0.f; }
            const float* wp = cw + (size_t)jj * D + c0;
#pragma unroll
            for (int e = 0; e < 8; ++e) y[e] += wp[e] * u[e];
            if (jj == 2 && t >= L - 2) { float* o = a->out + (smp ? O_SSC : O_PSC) + (((size_t)j * (smp ? NB_S : NB_P) + b) * 2 + (t - (L - 2))) * D + c0;
#pragma unroll
                for (int e = 0; e < 8; ++e) o[e] = u[e]; } }
        float bb[8]; bf16_t* bp = proj + (size_t)r * 3072 + c0; unpack8(*(const u32x4*)bp, bb);
#pragma unroll
        for (int e = 0; e < 8; ++e) y[e] *= bb[e];
        *(u32x4*)bp = pack8(y);
    }
}
__device__ __forceinline__ void ffn_fix_phase(const Frame& F, KArgs a, int l) {
    const bf16_t* ups = (const bf16_t*)(a->ws + WS_R2 + R2_UPS); const float* HB = (const float*)(a->ws + WS_R2 + R2_HB); const float* HF = (const float*)(a->ws + WS_R2 + R2_HF);
    bf16_t* act = (bf16_t*)(a->ws + WS_R1);
    const float* cw = a->in[18] + (size_t)l * 3 * DFF2; const float* sbuf = a->in[7] + (size_t)l * NB_S * 2 * DFF2;
    const int gw = F.vcu * NWAVES + F.wave, NGW = F.G * NWAVES, lane = F.lane;
    constexpr int NFIX = 56 * 2 * 6, NSMP = M_S * 6;
    for (int it = gw; it < NFIX + NSMP; it += NGW) {
        const bool fix = it < NFIX; const int it2 = fix ? it : it - NFIX, rI = it2 / 6, c0 = (it2 % 6) * 512 + 8 * lane; if (c0 >= DFF) continue;
        const int q0 = 256 * (c0 >> 7) + (c0 & 127);
        float uv[3][8], ug[3][8]; int row;
        if (fix) {
            const int tix = rI >> 1, rr = rI & 1, pm = tix + tix / 7 + 1; row = pm * 256 + rr;
#pragma unroll
            for (int jj = 0; jj < 3; ++jj) { const int d = 2 - jj, rel = rr - d;
                const float* src = rel < 0 ? HB + ((size_t)(pm - 1) * 2 + (2 + rel)) * DFF2 + q0 : HF + ((size_t)pm * 2 + rel) * DFF2 + q0;
#pragma unroll
                for (int e = 0; e < 8; ++e) { uv[jj][e] = src[e]; ug[jj][e] = src[128 + e]; } }
        } else {
            const int b = rI >> 3, t = rI & 7; row = M_P + rI;
#pragma unroll
            for (int jj = 0; jj < 3; ++jj) { const int d = 2 - jj;
                if (t - d >= 0) { unpack8(*(const u32x4*)(ups + (size_t)(rI - d) * DFF2 + q0), uv[jj]); unpack8(*(const u32x4*)(ups + (size_t)(rI - d) * DFF2 + q0 + 128), ug[jj]); }
                else { const float* p = sbuf + ((size_t)b * 2 + (t + jj)) * DFF2 + c0;
#pragma unroll
                    for (int e = 0; e < 8; ++e) { uv[jj][e] = p[e]; ug[jj][e] = p[DFF + e]; } } }
            if (t >= DSEQ - 2) { float* o = a->out + O_SFFN + (((size_t)l * NB_S + b) * 2 + (t - (DSEQ - 2))) * DFF2 + c0;
#pragma unroll
                for (int e = 0; e < 8; ++e) { o[e] = uv[2][e]; o[DFF + e] = ug[2][e]; } }
        }
        float yv[8], yg[8];
#pragma unroll
        for (int e = 0; e < 8; ++e) { yv[e] = 0.f; yg[e] = 0.f; }
#pragma unroll
        for (int jj = 0; jj < 3; ++jj) { const float* wp = cw + (size_t)jj * DFF2 + c0;
#pragma unroll
            for (int e = 0; e < 8; ++e) { yv[e] += wp[e] * uv[jj][e]; yg[e] += wp[DFF + e] * ug[jj][e]; } }
#pragma unroll
        for (int e = 0; e < 8; ++e) yv[e] *= siluf_(yg[e]);
        *(u32x4*)(act + (size_t)row * DFF + c0) = pack8(yv);
    }
}

enum Kind { K_P0 = 0, K_PROJ, K_DN_PRE, K_DN_SCAN, K_DN_GATE, K_SC_ACT, K_WOUT, K_UP, K_ACT, K_DOWN, K_GATE };
constexpr int N_PHASES = 1 + 9 + 7 + 9 + 7;
__host__ __device__ __forceinline__ void decode_phase(int p, int& l, int& kind) {
    if (p == 0) { l = 0; kind = K_P0; return; }
    p -= 1; l = 0;
    for (;;) { const int n = (l & 1) ? 7 : 9; if (p < n) break; p -= n; ++l; }
    const unsigned long long dnk = 0xA98764321ull  , sck = 0xA987651ull  ;
    kind = (int)((((l & 1) == 0 ? dnk : sck) >> (4 * p)) & 0xFull);
}

__global__ void __launch_bounds__(NTHR, 2) mk_fwd(Args args) {
    extern __shared__ __attribute__((aligned(16))) unsigned char lds_raw[];
    Frame F; F.lds = (LAS unsigned char*)lds_raw; F.tid = threadIdx.x; F.lane = F.tid & 63; F.wave = __builtin_amdgcn_readfirstlane(F.tid >> 6);
    F.G = gridDim.x; { const int bx = blockIdx.x; F.vcu = (F.G % 8 == 0) ? (bx % 8) * (F.G / 8) + bx / 8 : bx; }
    volatile LAS unsigned* MISC = (volatile LAS unsigned*)(F.lds + MISC_OFF);
    for (int u = F.tid; u < (LDS_BYTES - LDSCTL_OFF) / 4; u += NTHR) ((LAS unsigned*)(F.lds + LDSCTL_OFF))[u] = 0u;
    __syncthreads();
    const int ph_lo = args.ph_lo, ph_hi = args.ph_hi;
    XcdBarrier bar; bar.bar = (unsigned*)(args.ws + WS_CTL) + CW_BAR; bar.x = 0; bar.st = nullptr;
    if (ph_hi - ph_lo > 1) bar = xcd_barrier_post((unsigned*)(args.ws + WS_CTL) + CW_BAR, MISC + 8);
    int redo = 0;
    for (int p = ph_lo; p < ph_hi; ++p) {
        KArgs ka = (KArgs)__builtin_amdgcn_kernarg_segment_ptr(); asm volatile("" : "+s"(ka));
        { int t_ = threadIdx.x; asm volatile("" : "+v"(t_)); F.tid = t_; F.lane = t_ & 63; F.wave = __builtin_amdgcn_readfirstlane(t_ >> 6); }
        int l, kind; decode_phase(p, l, kind);
        const int j = l >> 1; const bool dn = (l & 1) == 0;
        unsigned char* ws = ka->ws;
        switch (kind) {
        case K_P0: p0_prologue(F, ka); break;
        case K_PROJ: {
            const int N = dn ? 4352 : 3072, Mb = dn ? M : M_P;
            pg8::Gemm g{(const bf16_t*)(ws + ((l & 1) ? WS_X1 : WS_X0)), wl_base(ka, l) + WL_IN, Mb, N, D, D}; pg8::StaticOrder S; S.init(Mb, N, F.G, (int)blockIdx.x);
            pg8::EpiBf16 E{(bf16_t*)(ws + WS_R1), dn ? PROJW : 3072, (float*)(ws + WS_BA), dn ? 16 : -1};
            pg8::gemm_phase<pg8::EpiBf16, pg8::StaticOrder>(F.lds, F.tid, g, S, E);
            if (!dn) pg8::small_gemm<pg8::EpiBf16>(F.lds, F.tid, F.vcu, F.G, g.A, D, g.Bt, D, 3072, E);
        } break;
        case K_DN_PRE: dn_chunk_phase(F, ka, j); break;
        case K_DN_SCAN: dn_scan_phase(F, ka, j); break;
        case K_DN_GATE: dn_gate_phase(F, ka, j); break;
        case K_SC_ACT: sc_act_phase(F, ka, j); break;
        case K_WOUT: {
            const bf16_t* R1 = (const bf16_t*)(ws + WS_R1);
            pg8::Gemm g{dn ? R1 + QKV : R1, wl_base(ka, l) + WL_OUT, M_P, D, D, dn ? PROJW : 3072}; pg8::StaticOrder S; S.init(M_P, D, F.G, (int)blockIdx.x);
            pg8::EpiResStats E{(bf16_t*)(ws + ((l & 1) ? WS_X1 : WS_X0)), (float*)(ws + WS_ST1)};
            pg8::gemm_phase<pg8::EpiResStats, pg8::StaticOrder>(F.lds, F.tid, g, S, E);
            pg8::small_gemm<pg8::EpiResStats>(F.lds, F.tid, F.vcu, F.G, g.A, g.lda, g.Bt, D, D, E);
        } break;
        case K_UP: {
            const float* vb = vec_base(ka, l);
            pg8::Gemm g{(const bf16_t*)(ws + ((l & 1) ? WS_X1 : WS_X0)), wl_base(ka, l) + WL_UP, M, DFF2, D, D}; pg8::StaticOrder S; S.init(M, DFF2, F.G, (int)blockIdx.x);
            pg8::EpiUpAct E{(bf16_t*)(ws + WS_R1), (bf16_t*)(ws + WS_R2 + R2_UPS), (float*)(ws + WS_R2 + R2_HB), (float*)(ws + WS_R2 + R2_HF), (const float*)(ws + WS_ST1), vb, vb + DFF2,
                            ka->in[18] + (size_t)l * 3 * DFF2, ka->out + O_PFFN + (size_t)l * NB_P * 2 * DFF2, (LAS float*)(F.lds + XA_OFF)};
            pg8::gemm_phase<pg8::EpiUpAct, pg8::StaticOrder>(F.lds, F.tid, g, S, E);
        } break;
        case K_ACT: {
            ffn_fix_phase(F, ka, l);
            pg8::Gemm g{(const bf16_t*)(ws + WS_PB) + (size_t)l * M * DPLE, wl_base(ka, l) + WL_P, M_P, D, DPLE, DPLE}; pg8::StaticOrder S; S.init(M_P, D, F.G, (int)blockIdx.x);
            pg8::EpiBf16 E{(bf16_t*)(ws + WS_R1) + (size_t)M * DFF, D, nullptr, -1};
            pg8::gemm_phase<pg8::EpiBf16, pg8::StaticOrder>(F.lds, F.tid, g, S, E);
            pg8::small_gemm<pg8::EpiBf16>(F.lds, F.tid, F.vcu, F.G, g.A, DPLE, g.Bt, DPLE, D, E);
        } break;
        case K_DOWN: {
            pg8::Gemm g{(const bf16_t*)(ws + WS_R1), wl_base(ka, l) + WL_DOWN, M_P, D, DFF, DFF}; pg8::StaticOrder S; S.init(M_P, D, F.G, (int)blockIdx.x);
            pg8::EpiLnResStats E{(bf16_t*)(ws + ((l & 1) ? WS_X1 : WS_X0)), (const float*)(ws + WS_ST1), (float*)(ws + WS_ST2), ka->in[20] + l * D, ka->in[21] + l * D};
            pg8::gemm_phase<pg8::EpiLnResStats, pg8::StaticOrder>(F.lds, F.tid, g, S, E);
            pg8::small_gemm<pg8::EpiLnResStats>(F.lds, F.tid, F.vcu, F.G, g.A, DFF, g.Bt, DFF, D, E);
        } break;
        case K_GATE: {
            const float* vb = vec_base(ka, l);
            const bf16_t* Xc = (const bf16_t*)(ws + ((l & 1) ? WS_X1 : WS_X0));
            pg8::Gemm g{Xc, wl_base(ka, l) + WL_G, M_P, D, D, D}; pg8::StaticOrder S; S.init(M_P, D, F.G, (int)blockIdx.x);
            pg8::EpiGate E{Xc, (const bf16_t*)(ws + WS_R1) + (size_t)M * DFF, (bf16_t*)(ws + ((l & 1) ? WS_X0 : WS_X1)), l == DEPTH - 1 ? ka->out + O_Y : nullptr, (const float*)(ws + WS_ST2),
                           vb + 2 * DFF2, vb + 2 * DFF2 + D, ka->in[22] + l * D, ka->in[23] + l * D};
            pg8::gemm_phase<pg8::EpiGate, pg8::StaticOrder>(F.lds, F.tid, g, S, E);
            pg8::small_gemm<pg8::EpiGate>(F.lds, F.tid, F.vcu, F.G, g.A, D, g.Bt, D, D, E);
        } break;
        default: break;
        }
        if (MK_DOUBLE_MASK) { if (((MK_DOUBLE_MASK >> kind) & 1) && !redo) { redo = 1; xcd_barrier(bar); --p; continue; } redo = 0; }
        if (p + 1 < ph_hi) xcd_barrier(bar);
    }
}

extern "C" void kernel_launch(void* const* d_in, const int* in_sizes, int n_in, void* d_out, int out_size, void* d_ws, size_t ws_size, hipStream_t stream) {
    static int grid = 0;
    if (grid == 0) {
        if (n_in != 26 || out_size != (int)O_END || ws_size < WS_END) { fprintf(stderr, "kernel_launch: unexpected shapes (n_in %d, out %d, ws %zu; need ws >= %zu)\n", n_in, out_size, ws_size, (size_t)WS_END); grid = -1; return; }
        int dev = 0, cus = 0;
        if (hipGetDevice(&dev) != hipSuccess || hipDeviceGetAttribute(&cus, hipDeviceAttributeMultiprocessorCount, dev) != hipSuccess) { grid = -1; return; }
        if (hipFuncSetAttribute((const void*)mk_fwd, hipFuncAttributeMaxDynamicSharedMemorySize, LDS_BYTES) != hipSuccess) { fprintf(stderr, "kernel_launch: hipFuncSetAttribute failed\n"); grid = -1; return; }
        int per_cu = 0; (void)hipOccupancyMaxActiveBlocksPerMultiprocessor(&per_cu, (const void*)mk_fwd, NTHR, LDS_BYTES); (void)hipGetLastError();
        grid = cus;
    }
    if (grid < 0) return;
    (void)hipMemsetAsync((char*)d_ws + WS_CTL, 0, CTL_ZERO_BYTES, stream);
    Args a{};
    for (int i = 0; i < 26; ++i) a.in[i] = (const float*)d_in[i];
    a.out = (float*)d_out; a.ws = (unsigned char*)d_ws;
#if MK_PER_PHASE_LAUNCH
    for (int p = 0; p < N_PHASES; ++p) { a.ph_lo = p; a.ph_hi = p + 1; hipLaunchKernelGGL(mk_fwd, dim3(grid), dim3(NTHR), LDS_BYTES, stream, a); }
#else
    a.ph_lo = 0; a.ph_hi = N_PHASES; hipLaunchKernelGGL(mk_fwd, dim3(grid), dim3(NTHR), LDS_BYTES, stream, a);
#endif
}
```
